# Optimizing an MI355X kernel written in HIP

```python
import math
import jax, jax.numpy as jnp
from jax import lax
import numpy as np

D_MODEL = 2048
BATCH = 2
SEQ = 16384
DEPTH = 2

GRID_W = 64
CTX_LEN = 256
D_FF = 5632
EPS = 1e-6
ROPE_THETA = 10000.0
Q_BLOCK = 128
N_BRANCH = 3
N_MOD = 9

LRU_WIDTH = 1024
LRU_BLOCKS = 8
LRU_BLOCK = LRU_WIDTH // LRU_BLOCKS
CONV_W = 4
LRU_C = 8.0

MLA_HEADS = 8
MLA_Q_RANK = 512
MLA_KV_RANK = 256
MLA_NOPE = 128
MLA_ROPE = 64
MLA_V = 128
MLA_QK = MLA_NOPE + MLA_ROPE

DIFF_HEADS = 8
DIFF_D = 64
DIFF_V = 2 * DIFF_D

BRANCH_W = 1024

IN_SIZES = (LRU_WIDTH, LRU_WIDTH, MLA_Q_RANK, MLA_KV_RANK, MLA_ROPE,
            DIFF_HEADS * 2 * DIFF_D, DIFF_HEADS * 2 * DIFF_D, DIFF_HEADS * DIFF_V,
            N_BRANCH * D_MODEL)
N_IN = sum(IN_SIZES)

kernel_name = "hybrid_rglru_mla_diffattn_macaron_dit"


def rmsnorm(x, g):
    xf = x.astype(jnp.float32)
    xf = xf * lax.rsqrt(jnp.mean(xf * xf, axis=-1, keepdims=True) + EPS)
    return (xf * g.astype(jnp.float32)).astype(x.dtype)


def split_in(proj):
    offsets, acc = [], 0
    for s in IN_SIZES[:-1]:
        acc += s
        offsets.append(acc)
    return jnp.split(proj, offsets, axis=-1)


def modulate(h, mod, s):
    return h * (1.0 + mod[:, 3 * s][:, None, :]) + mod[:, 3 * s + 1][:, None, :]


def gate_of(mod, s):
    return mod[:, 3 * s + 2][:, None, :]


def swiglu(h, w_gate, w_up, w_down):
    return (jax.nn.silu(h @ w_gate) * (h @ w_up)) @ w_down


def axial_rope(n_tokens, rot_dim):
    rows = n_tokens // GRID_W
    axis_dim = rot_dim // 2
    inv_freq = ROPE_THETA ** (-jnp.arange(0, axis_dim, 2, dtype=jnp.float32) / axis_dim)
    nf = axis_dim // 2
    row_ang = jnp.arange(rows, dtype=jnp.float32)[:, None] * inv_freq
    col_ang = jnp.arange(GRID_W, dtype=jnp.float32)[:, None] * inv_freq
    ang = jnp.concatenate([jnp.broadcast_to(row_ang[:, None, :], (rows, GRID_W, nf)),
                           jnp.broadcast_to(col_ang[None, :, :], (rows, GRID_W, nf))], axis=-1)
    ang = ang.reshape(rows * GRID_W, axis_dim)
    return jnp.cos(ang), jnp.sin(ang)


def apply_rope(x, cos, sin):
    half = x.shape[-1] // 2
    shape = (1, x.shape[1]) + (1,) * (x.ndim - 3) + (half,)
    cs = cos.reshape(shape).astype(x.dtype)
    sn = sin.reshape(shape).astype(x.dtype)
    x1, x2 = x[..., :half], x[..., half:]
    return jnp.concatenate([x1 * cs - x2 * sn, x1 * sn + x2 * cs], axis=-1)


def sweep_query_blocks(fn, q):
    b, n = q.shape[:2]
    nb = n // Q_BLOCK
    qb = jnp.moveaxis(q.reshape((b, nb, Q_BLOCK) + q.shape[2:]), 1, 0)
    out = jnp.moveaxis(lax.map(fn, qb), 0, 1)
    return out.reshape((b, n) + out.shape[3:])


def centred_dwconv(x, w, b):
    n = x.shape[1]
    left = CONV_W // 2
    xp = jnp.pad(x, ((0, 0), (left, CONV_W - 1 - left), (0, 0)))
    y = b + xp[:, 0:n] * w[0]
    for j in range(1, CONV_W):
        y = y + xp[:, j:j + n] * w[j]
    return y


def block_diag(x, w, b):
    xb = x.reshape(x.shape[:-1] + (LRU_BLOCKS, LRU_BLOCK))
    return jnp.einsum('blni,nij->blnj', xb, w).reshape(x.shape) + b


def _affine_combine(left, right):
    return (left[0] * right[0], right[0] * left[1] + right[1])


def rglru_scan(x, h0, wa, ba, wx, bx, lam, reverse):
    xf = x.astype(jnp.float32)
    r = jax.nn.sigmoid(block_diag(x, wa, ba).astype(jnp.float32))
    i = jax.nn.sigmoid(block_diag(x, wx, bx).astype(jnp.float32))
    log_a = -LRU_C * r * jax.nn.softplus(-lam.astype(jnp.float32))
    a = jnp.exp(log_a)
    u = jnp.sqrt(1.0 - jnp.exp(2.0 * log_a)) * (i * xf)
    if reverse:
        a, u = a[:, ::-1], u[:, ::-1]
    u = u.at[:, 0].add(a[:, 0] * h0)
    _, h = lax.associative_scan(_affine_combine, (a, u), axis=1)
    return h[:, ::-1] if reverse else h


def rglru_branch(x_ctx, g_ctx, x_lat, g_lat, p, need_ctx_out):
    xc = centred_dwconv(x_ctx, p['lru_conv_w'], p['lru_conv_b'])
    xl = centred_dwconv(x_lat, p['lru_conv_w'], p['lru_conv_b'])
    h_zero = jnp.zeros((x_ctx.shape[0], LRU_WIDTH), jnp.float32)
    hl_sum, hc_sum = None, None
    for d, rev in enumerate((False, True)):
        prm = (p['lru_wa'][d], p['lru_ba'][d], p['lru_wx'][d], p['lru_bx'][d], p['lru_lambda'][d])
        hc = rglru_scan(xc, h_zero, *prm, reverse=rev)
        hc_final = hc[:, 0] if rev else hc[:, -1]
        hl = rglru_scan(xl, hc_final, *prm, reverse=rev)
        hl_sum = hl if hl_sum is None else hl_sum + hl
        hc_sum = hc if hc_sum is None else hc_sum + hc
    y_lat = (hl_sum * jax.nn.gelu(g_lat.astype(jnp.float32))).astype(x_lat.dtype)
    y_ctx = None
    if need_ctx_out:
        y_ctx = (hc_sum * jax.nn.gelu(g_ctx.astype(jnp.float32))).astype(x_ctx.dtype)
    return y_ctx, y_lat


def mla_qkv(qc, kvc, kr, p, rope):
    b, n = qc.shape[:2]
    q = (rmsnorm(qc, p['mla_qc_norm']) @ p['mla_w_uq']).reshape(b, n, MLA_HEADS, MLA_QK)
    kv = (rmsnorm(kvc, p['mla_kvc_norm']) @ p['mla_w_ukv']).reshape(b, n, MLA_HEADS, MLA_NOPE + MLA_V)
    k_nope, v = kv[..., :MLA_NOPE], kv[..., MLA_NOPE:]
    k_rope = jnp.broadcast_to(kr[:, :, None, :], (b, n, MLA_HEADS, MLA_ROPE))
    k = jnp.concatenate([k_nope, k_rope], axis=-1)
    q = rmsnorm(q, p['mla_q_norm'])
    k = rmsnorm(k, p['mla_k_norm'])
    if rope is not None:
        cos, sin = rope
        q = jnp.concatenate([q[..., :MLA_NOPE], apply_rope(q[..., MLA_NOPE:], cos, sin)], axis=-1)
        k = jnp.concatenate([k[..., :MLA_NOPE], apply_rope(k[..., MLA_NOPE:], cos, sin)], axis=-1)
    return q, k, v


def mla_attend(q, k, v):
    s = jnp.einsum('bqhd,bkhd->bhqk', q, k).astype(jnp.float32) * (MLA_QK ** -0.5)
    pr = jax.nn.softmax(s, axis=-1).astype(v.dtype)
    return jnp.einsum('bhqk,bkhe->bqhe', pr, v)


def diff_qkv(dq, dk, dv, p, rope):
    b, n = dq.shape[:2]
    q = rmsnorm(dq.reshape(b, n, DIFF_HEADS, 2, DIFF_D), p['diff_q_norm'])
    k = rmsnorm(dk.reshape(b, n, DIFF_HEADS, 2, DIFF_D), p['diff_k_norm'])
    v = dv.reshape(b, n, DIFF_HEADS, DIFF_V)
    if rope is not None:
        cos, sin = rope
        q = apply_rope(q, cos, sin)
        k = apply_rope(k, cos, sin)
    return q, k, v


def diff_attend(q, k, v, lam):
    s = jnp.einsum('bqhcd,bkhcd->bchqk', q, k).astype(jnp.float32) * (DIFF_D ** -0.5)
    pr = jax.nn.softmax(s, axis=-1)
    pd = (pr[:, 0] - lam * pr[:, 1]).astype(v.dtype)
    return jnp.einsum('bhqk,bkhe->bqhe', pd, v)


def diff_out(o, p, lam_init):
    b, n = o.shape[:2]
    return (rmsnorm(o, p['diff_out_norm']) * (1.0 - lam_init)).reshape(b, n, DIFF_HEADS * DIFF_V)


def merge(branches, gate_cols, branch_proj, w_out):
    g = jax.nn.sigmoid(gate_cols.reshape(gate_cols.shape[:-1] + (N_BRANCH, D_MODEL)))
    acc = g[..., 0, :] * (branches[0] @ branch_proj[0])
    for j in range(1, N_BRANCH):
        acc = acc + g[..., j, :] * (branches[j] @ branch_proj[j])
    return acc @ w_out


def mixer(h_lat, h_ctx, p, lam_init, need_ctx_out):
    b, n = h_lat.shape[:2]
    rx_l, rg_l, qc_l, kvc_l, kr_l, dq_l, dk_l, dv_l, gt_l = split_in(h_lat @ p['w_in'])
    rx_c, rg_c, qc_c, kvc_c, kr_c, dq_c, dk_c, dv_c, gt_c = split_in(h_ctx @ p['w_in'])

    a_ctx, a_lat = rglru_branch(rx_c, rg_c, rx_l, rg_l, p, need_ctx_out)

    q_ml, k_ml, v_ml = mla_qkv(qc_l, kvc_l, kr_l, p, axial_rope(n, MLA_ROPE))
    q_mc, k_mc, v_mc = mla_qkv(qc_c, kvc_c, kr_c, p, None)
    k_m_all = jnp.concatenate([k_mc, k_ml], axis=1)
    v_m_all = jnp.concatenate([v_mc, v_ml], axis=1)
    b_lat = sweep_query_blocks(lambda qi: mla_attend(qi, k_m_all, v_m_all), q_ml).reshape(b, n, MLA_HEADS * MLA_V)

    lam_p = p['diff_lambda'].astype(jnp.float32)
    lam = jnp.exp(jnp.sum(lam_p[0] * lam_p[1])) - jnp.exp(jnp.sum(lam_p[2] * lam_p[3])) + lam_init
    q_dl, k_dl, v_dl = diff_qkv(dq_l, dk_l, dv_l, p, axial_rope(n, DIFF_D))
    q_dc, k_dc, v_dc = diff_qkv(dq_c, dk_c, dv_c, p, None)
    k_d_all = jnp.concatenate([k_dc, k_dl], axis=1)
    v_d_all = jnp.concatenate([v_dc, v_dl], axis=1)
    c_lat = diff_out(sweep_query_blocks(lambda qi: diff_attend(qi, k_d_all, v_d_all, lam), q_dl), p, lam_init)

    y_lat = merge((a_lat, b_lat, c_lat), gt_l, p['branch_proj'], p['w_out'])
    y_ctx = None
    if need_ctx_out:
        bc, nc = h_ctx.shape[:2]
        b_ctx = mla_attend(q_mc, k_mc, v_mc).reshape(bc, nc, MLA_HEADS * MLA_V)
        c_ctx_o = diff_out(diff_attend(q_dc, k_dc, v_dc, lam), p, lam_init)
        y_ctx = merge((a_ctx, b_ctx, c_ctx_o), gt_c, p['branch_proj'], p['w_out'])
    return y_lat, y_ctx


def setup_inputs(seed: int = 0) -> dict:
    key = jax.random.key(seed)
    ks = jax.random.split(key, 32)

    def nrm(k, shape, fan_in, mult=1.0):
        return jax.random.normal(k, shape, jnp.float32) * (mult * fan_in ** -0.5)

    def gain(k, shape):
        return 1.0 + 0.01 * jax.random.normal(k, shape, jnp.float32)

    a0 = jax.random.uniform(ks[17], (DEPTH, 2, LRU_WIDTH), jnp.float32, minval=0.9, maxval=0.999)
    s0 = a0 ** (1.0 / LRU_C)
    lru_lambda = jnp.log(s0) - jnp.log1p(-s0)
    return {
        "x": jax.random.normal(ks[0], (BATCH, SEQ, D_MODEL), jnp.float32),
        "c": jax.random.normal(ks[1], (BATCH, D_MODEL), jnp.float32),
        "ctx": jax.random.normal(ks[2], (BATCH, CTX_LEN, D_MODEL), jnp.float32),
        "c_ctx": jax.random.normal(ks[3], (D_MODEL,), jnp.float32),
        "w_mod": nrm(ks[4], (DEPTH, D_MODEL, N_MOD * D_MODEL), D_MODEL, 0.5),
        "b_mod": 0.01 * jax.random.normal(ks[5], (DEPTH, N_MOD * D_MODEL), jnp.float32),
        "norm_g": gain(ks[6], (DEPTH, 3, D_MODEL)),
        "ffn_w_gate": nrm(ks[7], (DEPTH, 2, D_MODEL, D_FF), D_MODEL),
        "ffn_w_up": nrm(ks[8], (DEPTH, 2, D_MODEL, D_FF), D_MODEL),
        "ffn_w_down": nrm(ks[9], (DEPTH, 2, D_FF, D_MODEL), D_FF),
        "w_in": nrm(ks[10], (DEPTH, D_MODEL, N_IN), D_MODEL),
        "lru_conv_w": nrm(ks[11], (DEPTH, CONV_W, LRU_WIDTH), CONV_W),
        "lru_conv_b": 0.01 * jax.random.normal(ks[12], (DEPTH, LRU_WIDTH), jnp.float32),
        "lru_wa": nrm(ks[13], (DEPTH, 2, LRU_BLOCKS, LRU_BLOCK, LRU_BLOCK), LRU_BLOCK),
        "lru_ba": 0.01 * jax.random.normal(ks[14], (DEPTH, 2, LRU_WIDTH), jnp.float32),
        "lru_wx": nrm(ks[15], (DEPTH, 2, LRU_BLOCKS, LRU_BLOCK, LRU_BLOCK), LRU_BLOCK),
        "lru_bx": 0.01 * jax.random.normal(ks[16], (DEPTH, 2, LRU_WIDTH), jnp.float32),
        "lru_lambda": lru_lambda,
        "mla_qc_norm": gain(ks[18], (DEPTH, MLA_Q_RANK)),
        "mla_kvc_norm": gain(ks[19], (DEPTH, MLA_KV_RANK)),
        "mla_w_uq": nrm(ks[20], (DEPTH, MLA_Q_RANK, MLA_HEADS * MLA_QK), MLA_Q_RANK),
        "mla_w_ukv": nrm(ks[21], (DEPTH, MLA_KV_RANK, MLA_HEADS * (MLA_NOPE + MLA_V)), MLA_KV_RANK),
        "mla_q_norm": gain(ks[22], (DEPTH, MLA_QK)),
        "mla_k_norm": gain(ks[23], (DEPTH, MLA_QK)),
        "diff_q_norm": gain(ks[24], (DEPTH, DIFF_D)),
        "diff_k_norm": gain(ks[25], (DEPTH, DIFF_D)),
        "diff_lambda": 0.1 * jax.random.normal(ks[26], (DEPTH, 4, DIFF_D), jnp.float32),
        "diff_out_norm": gain(ks[27], (DEPTH, DIFF_V)),
        "branch_proj": nrm(ks[28], (DEPTH, N_BRANCH, BRANCH_W, D_MODEL), BRANCH_W),
        "w_out": nrm(ks[29], (DEPTH, D_MODEL, D_MODEL), D_MODEL),
    }


def reference(x, c, ctx, c_ctx, w_mod, b_mod, norm_g, ffn_w_gate, ffn_w_up, ffn_w_down,
              w_in, lru_conv_w, lru_conv_b, lru_wa, lru_ba, lru_wx, lru_bx, lru_lambda,
              mla_qc_norm, mla_kvc_norm, mla_w_uq, mla_w_ukv, mla_q_norm, mla_k_norm,
              diff_q_norm, diff_k_norm, diff_lambda, diff_out_norm, branch_proj, w_out):
    xl, xc = x, ctx
    silu_c = jax.nn.silu(c)
    silu_cc = jax.nn.silu(c_ctx)[None, :]
    for l in range(DEPTH):
        last = l == DEPTH - 1
        p = {
            'w_in': w_in[l], 'lru_conv_w': lru_conv_w[l], 'lru_conv_b': lru_conv_b[l],
            'lru_wa': lru_wa[l], 'lru_ba': lru_ba[l], 'lru_wx': lru_wx[l], 'lru_bx': lru_bx[l],
            'lru_lambda': lru_lambda[l], 'mla_qc_norm': mla_qc_norm[l], 'mla_kvc_norm': mla_kvc_norm[l],
            'mla_w_uq': mla_w_uq[l], 'mla_w_ukv': mla_w_ukv[l], 'mla_q_norm': mla_q_norm[l],
            'mla_k_norm': mla_k_norm[l], 'diff_q_norm': diff_q_norm[l], 'diff_k_norm': diff_k_norm[l],
            'diff_lambda': diff_lambda[l], 'diff_out_norm': diff_out_norm[l],
            'branch_proj': branch_proj[l], 'w_out': w_out[l],
        }
        mod_l = (silu_c @ w_mod[l] + b_mod[l]).reshape(-1, N_MOD, D_MODEL)
        mod_c = (silu_cc @ w_mod[l] + b_mod[l]).reshape(1, N_MOD, D_MODEL)
        lam_init = 0.8 - 0.6 * math.exp(-0.3 * l)

        f1 = (ffn_w_gate[l, 0], ffn_w_up[l, 0], ffn_w_down[l, 0])
        xl = xl + 0.5 * gate_of(mod_l, 0) * swiglu(modulate(rmsnorm(xl, norm_g[l, 0]), mod_l, 0), *f1)
        xc = xc + 0.5 * gate_of(mod_c, 0) * swiglu(modulate(rmsnorm(xc, norm_g[l, 0]), mod_c, 0), *f1)

        h_lat = modulate(rmsnorm(xl, norm_g[l, 1]), mod_l, 1)
        h_ctx = modulate(rmsnorm(xc, norm_g[l, 1]), mod_c, 1)
        y_lat, y_ctx = mixer(h_lat, h_ctx, p, lam_init, not last)
        xl = xl + gate_of(mod_l, 1) * y_lat

        f2 = (ffn_w_gate[l, 1], ffn_w_up[l, 1], ffn_w_down[l, 1])
        xl = xl + 0.5 * gate_of(mod_l, 2) * swiglu(modulate(rmsnorm(xl, norm_g[l, 2]), mod_l, 2), *f2)
        if not last:
            xc = xc + gate_of(mod_c, 1) * y_ctx
            xc = xc + 0.5 * gate_of(mod_c, 2) * swiglu(modulate(rmsnorm(xc, norm_g[l, 2]), mod_c, 2), *f2)
    return xl
```

```cpp
#include <hip/hip_runtime.h>
#include <cstdio>
#include <cstdint>
#ifndef MK_FUSED
#define MK_FUSED 0
#endif
#define PH_LIMIT 34
namespace pg8 {
#define PG8_LAS __attribute__((address_space(3)))
typedef unsigned short bf16_t;
typedef short bf16x8 __attribute__((ext_vector_type(8)));
typedef float f32x4 __attribute__((ext_vector_type(4)));
typedef unsigned u32x4 __attribute__((ext_vector_type(4)));
constexpr int BM = 256, BK = 64, HALF = 128, HTB = HALF * BK * 2  , STAGE_BYTES = 8 * HTB, NXCD = 8, WGM = 8;

__host__ __device__ __forceinline__ int lds_byte(int r, int c) { const int st = (r >> 4) * 2 + (c >> 5), rr = r & 15, cc = c & 31, ob = rr * 64 + cc * 2; return st * 1024 + (ob ^ (((ob >> 9) & 1) << 5)); }
__host__ __device__ __forceinline__ void stage_rc(int b, int& R, int& C) { const int st = b / 1024, sb = b % 1024, swz = sb ^ (((sb >> 9) & 1) << 5); R = (st >> 1) * 16 + swz / 64; C = (st & 1) * 32 + (swz % 64) / 2; }
__host__ __device__ __forceinline__ int perm32(int rho) { const int n = rho >> 4, i = rho & 15; return 8 * (i >> 2) + 4 * n + (i & 3); }

struct Unit { int pm, pn; };
struct Gemm { const bf16_t* A; const bf16_t* Bt; int M, N, K, lda, ldb; };

struct StaticOrder {
    int nM, nN, nwg, G, c;
    __host__ __device__ void init(int M, int N, int G_, int c_) { nM = M / BM; nN = N / BM; nwg = nM * nN; G = G_; c = c_; }
    __host__ __device__ bool next(int i, Unit& u) const {
        const long L = (long)i * G + c; if (L >= nwg) return false;
        int wgid = (int)L; { const int q = nwg / NXCD, r = nwg % NXCD, xcd = wgid % NXCD, off = wgid / NXCD; wgid = (xcd < r ? xcd * (q + 1) : r * (q + 1) + (xcd - r) * q) + off; }
        const int nig = WGM * nN, gid = wgid / nig, fm = gid * WGM, gsz = (nM - fm) < WGM ? (nM - fm) : WGM;
        u.pm = fm + ((wgid % nig) % gsz); u.pn = (wgid % nig) / gsz; return true;
    }
    __device__ __forceinline__ void a_ready(const Unit&) const {}
    __device__ __forceinline__ void done(const Unit&) const {}
};

typedef float f32x2_c __attribute__((ext_vector_type(2))); typedef __bf16 bf16x2_c __attribute__((ext_vector_type(2)));
__device__ __forceinline__ unsigned cvt_pk_bf16(float lo, float hi) { f32x2_c v = {lo, hi}; bf16x2_c b = __builtin_convertvector(v, bf16x2_c); return __builtin_bit_cast(unsigned, b); }
typedef float f32x2 __attribute__((ext_vector_type(2)));
__device__ __forceinline__ f32x2 gelu_pk(f32x2 v) {
    const f32x2 av = __builtin_elementwise_abs(v), d = av * 0.2316418882f + 1.0f;
    f32x2 t; t.x = __builtin_amdgcn_rcpf(d.x); t.y = __builtin_amdgcn_rcpf(d.y);
    f32x2 q = t * 0.5307027145f + (-0.7265760135f); q = q * t + 0.7107068705f; q = q * t + (-0.142248368f); q = q * t + 0.127414796f; q = q * t;
    const f32x2 s = (v * v) * (-0.72134752044f);
    f32x2 e; e.x = __builtin_amdgcn_exp2f(s.x); e.y = __builtin_amdgcn_exp2f(s.y);
    const f32x2 m = v * (q * e), r = v - m;
    f32x2 o; o.x = v.x < 0.f ? m.x : r.x; o.y = v.y < 0.f ? m.y : r.y; return o;
}

__device__ __forceinline__ float sigmoid_f(float x) { return __builtin_amdgcn_rcpf(1.f + __builtin_amdgcn_exp2f(-1.4426950408889634f * x)); }
__device__ __forceinline__ float silu_f(float x) { return x * sigmoid_f(x); }
__device__ __forceinline__ float gelu_tanh_f(float x) { const float z = 0.7978845608028654f * (x + 0.044715f * x * x * x); return x * sigmoid_f(2.f * z); }
__device__ __forceinline__ float bf_lo(unsigned w) { return __uint_as_float(w << 16); }
__device__ __forceinline__ float bf_hi(unsigned w) { return __uint_as_float(w & 0xffff0000u); }

struct EpiSwiglu {
    static constexpr bool PERM = true, AFTER_DRAIN = false;
    bf16_t* O; int ldc;
    __device__ __forceinline__ void operator()(const f32x4 (&acc)[2][2][4][2], const Unit& u, int wr, int wc, int fr, int fq) const {
        const int row0 = u.pm * BM + wr * 64 + fr, col0 = u.pn * HALF + wc * 32 + 8 * fq;
#pragma unroll
        for (int ai = 0; ai < 2; ++ai)
#pragma unroll
            for (int m = 0; m < 4; ++m) {
                bf16_t* rowp = O + (size_t)(row0 + ai * HALF + m * 16) * ldc + col0;
                const f32x4 g0 = acc[ai][0][m][0], g1 = acc[ai][0][m][1], u0 = acc[ai][1][m][0], u1 = acc[ai][1][m][1];
                u32x4 w;
                w.x = cvt_pk_bf16(silu_f(g0[0]) * u0[0], silu_f(g0[1]) * u0[1]); w.y = cvt_pk_bf16(silu_f(g0[2]) * u0[2], silu_f(g0[3]) * u0[3]);
                w.z = cvt_pk_bf16(silu_f(g1[0]) * u1[0], silu_f(g1[1]) * u1[1]); w.w = cvt_pk_bf16(silu_f(g1[2]) * u1[2], silu_f(g1[3]) * u1[3]);
                *(u32x4*)rowp = w;
            }
    }
};
struct EpiResid {
    static constexpr bool PERM = false, AFTER_DRAIN = false;
    const float* base_lat; const float* base_ctx; float* out_lat; float* out_ctx; const float* gate; float gs;
    __device__ __forceinline__ void operator()(const f32x4 (&acc)[2][2][4][2], const Unit& u, int wr, int wc, int fr, int fq) const {
        const bool isl = u.pm < 128;
        const float* base = isl ? base_lat + (size_t)u.pm * BM * 2048 : base_ctx + (size_t)(u.pm - 128) * BM * 2048;
        float* out = isl ? out_lat + (size_t)u.pm * BM * 2048 : out_ctx + (size_t)(u.pm - 128) * BM * 2048;
        const int mrow = u.pm < 64 ? 0 : (u.pm < 128 ? 1 : 2);
        const float* gp = gate + (size_t)mrow * 18432;
        const int col0 = u.pn * BM + wc * 32 + 4 * fq;
#pragma unroll
        for (int bj = 0; bj < 2; ++bj)
#pragma unroll
            for (int n = 0; n < 2; ++n) {
                const f32x4 gv = *(const f32x4*)(gp + col0 + bj * HALF + n * 16) * gs;
#pragma unroll
                for (int ai = 0; ai < 2; ++ai)
#pragma unroll
                    for (int m = 0; m < 4; ++m) {
                        const size_t off = (size_t)(ai * HALF + wr * 64 + m * 16 + fr) * 2048 + col0 + bj * HALF + n * 16;
                        const f32x4 b = *(const f32x4*)(base + off);
                        *(f32x4*)(out + off) = b + gv * acc[ai][bj][m][n];
                    }
            }
    }
};
template <int ACT> struct EpiAct {
    static constexpr bool PERM = true, AFTER_DRAIN = false;
    bf16_t* O; int ldc;
    __device__ __forceinline__ void operator()(const f32x4 (&acc)[2][2][4][2], const Unit& u, int wr, int wc, int fr, int fq) const {
        const int row0 = u.pm * BM + wr * 64 + fr, col0 = u.pn * BM + wc * 32 + 8 * fq;
        const bool dog = (ACT == 1) && (u.pn >= 4 && u.pn < 8);
#pragma unroll
        for (int ai = 0; ai < 2; ++ai)
#pragma unroll
            for (int m = 0; m < 4; ++m) {
                bf16_t* rowp = O + (size_t)(row0 + ai * HALF + m * 16) * ldc + col0;
#pragma unroll
                for (int bj = 0; bj < 2; ++bj) {
                    f32x4 v0 = acc[ai][bj][m][0], v1 = acc[ai][bj][m][1];
                    if (ACT == 1) { if (dog) {
#pragma unroll
                        for (int j = 0; j < 4; ++j) { v0[j] = gelu_tanh_f(v0[j]); v1[j] = gelu_tanh_f(v1[j]); } } }
                    if (ACT == 2) {
#pragma unroll
                        for (int j = 0; j < 4; ++j) { v0[j] = sigmoid_f(v0[j]); v1[j] = sigmoid_f(v1[j]); } }
                    u32x4 w; w.x = cvt_pk_bf16(v0[0], v0[1]); w.y = cvt_pk_bf16(v0[2], v0[3]); w.z = cvt_pk_bf16(v1[0], v1[1]); w.w = cvt_pk_bf16(v1[2], v1[3]);
                    *(u32x4*)(rowp + bj * HALF) = w;
                }
            }
    }
};
template <int J> struct EpiMerge {
    static constexpr bool PERM = true, AFTER_DRAIN = false;
    bf16_t* R; const bf16_t* gates;
    __device__ __forceinline__ void operator()(const f32x4 (&acc)[2][2][4][2], const Unit& u, int wr, int wc, int fr, int fq) const {
        const int row0 = u.pm * BM + wr * 64 + fr, col0 = u.pn * BM + wc * 32 + 8 * fq;
#pragma unroll
        for (int ai = 0; ai < 2; ++ai)
#pragma unroll
            for (int m = 0; m < 4; ++m) {
                const size_t row = (size_t)(row0 + ai * HALF + m * 16);
#pragma unroll
                for (int bj = 0; bj < 2; ++bj) {
                    const u32x4 gw = *(const u32x4*)(gates + row * 6144 + J * 2048 + col0 + bj * HALF);
                    bf16_t* rp = R + row * 2048 + col0 + bj * HALF;
                    u32x4 ro = (u32x4){0u, 0u, 0u, 0u}; if (J > 0) ro = *(const u32x4*)rp;
                    const f32x4 v0 = acc[ai][bj][m][0], v1 = acc[ai][bj][m][1];
                    u32x4 w;
                    w.x = cvt_pk_bf16(bf_lo(ro.x) + bf_lo(gw.x) * v0[0], bf_hi(ro.x) + bf_hi(gw.x) * v0[1]);
                    w.y = cvt_pk_bf16(bf_lo(ro.y) + bf_lo(gw.y) * v0[2], bf_hi(ro.y) + bf_hi(gw.y) * v0[3]);
                    w.z = cvt_pk_bf16(bf_lo(ro.z) + bf_lo(gw.z) * v1[0], bf_hi(ro.z) + bf_hi(gw.z) * v1[1]);
                    w.w = cvt_pk_bf16(bf_lo(ro.w) + bf_lo(gw.w) * v1[2], bf_hi(ro.w) + bf_hi(gw.w) * v1[3]);
                    *(u32x4*)rp = w;
                }
            }
    }
};
template <class Epi, class Sched, bool ALIGN_EPI = false, bool SP2 = false>
__device__ __forceinline__ void gemm_phase(PG8_LAS unsigned char* lds, const Gemm g, const Sched& S, const Epi& E) {
    const int tid = threadIdx.x, wid = __builtin_amdgcn_readfirstlane(tid >> 6), lane = tid & 63, wr = wid >> 2, wc = wid & 3, fr = lane & 15, fq = lane >> 4;
    const int K = g.K, nt = K / BK;
    unsigned voffA[2], voffB[2];
#pragma unroll
    for (int i = 0; i < 2; ++i) { int R, C; stage_rc(tid * 16 + i * 8192, R, C); const int Rb = Epi::PERM ? ((R & ~31) + perm32(R & 31)) : R;
        voffA[i] = (unsigned)(R * g.lda + C) * 2u; voffB[i] = (unsigned)(Rb * g.ldb + C) * 2u; }
    const size_t kstep = (size_t)(BK * 2);
    const size_t hstepA = (size_t)HALF * g.lda * 2, hstepB = (size_t)HALF * g.ldb * 2;
    const size_t tstepA = 2 * hstepA, tstepB = 2 * hstepB;
    const unsigned ldsw = (unsigned)wid * 1024u;
    const int aoff = lds_byte(wr * 64 + fr, fq * 8), boff = lds_byte(wc * 32 + fr, fq * 8);
#define PG8_SA(b, h) (((b) * 2 + (h)) * HTB)
#define PG8_SB(b, h) ((4 + (b) * 2 + (h)) * HTB)
#define PG8_STAGE(bufoff, gbase, voff) do { _Pragma("unroll") for (int _i = 0; _i < 2; ++_i) \
        __builtin_amdgcn_global_load_lds((const unsigned*)((const char*)(gbase) + (voff)[_i]), (PG8_LAS unsigned*)(lds + (bufoff) + ldsw + _i * 8192), 16, 0, 0); } while (0)
#define PG8_LDA(dst, b, h) do { _Pragma("unroll") for (int m = 0; m < 4; ++m) _Pragma("unroll") for (int k = 0; k < 2; ++k) dst[m][k] = *(const PG8_LAS bf16x8*)(lds + PG8_SA(b, h) + aoff + m * 2048 + k * 1024); } while (0)
#define PG8_LDB(dst, b, h) do { _Pragma("unroll") for (int n = 0; n < 2; ++n) _Pragma("unroll") for (int k = 0; k < 2; ++k) dst[n][k] = *(const PG8_LAS bf16x8*)(lds + PG8_SB(b, h) + boff + n * 2048 + k * 1024); } while (0)
#define PG8_MMA(ai, bj, At, Bt) do { __builtin_amdgcn_s_setprio(1); _Pragma("unroll") for (int m = 0; m < 4; ++m) _Pragma("unroll") for (int n = 0; n < 2; ++n) _Pragma("unroll") for (int k = 0; k < 2; ++k) \
        acc[ai][bj][m][n] = __builtin_amdgcn_mfma_f32_16x16x32_bf16(Bt[n][k], At[m][k], acc[ai][bj][m][n], 0, 0, 0); __builtin_amdgcn_s_setprio(0); } while (0)
#define PG8_WAIT_V(n) asm volatile("s_waitcnt vmcnt(" #n ")" ::: "memory")
#define PG8_WAIT_L(n) asm volatile("s_waitcnt lgkmcnt(" #n ")" ::: "memory")
#define PG8_BAR __builtin_amdgcn_s_barrier()
#define PG8_SCHED __builtin_amdgcn_sched_barrier(0)
    Unit cur, nxt; int ui = 0;
    if (!S.next(0, cur)) return;
    f32x4 acc[2][2][4][2];
#pragma unroll
    for (int a = 0; a < 2; ++a)
#pragma unroll
        for (int b = 0; b < 2; ++b)
#pragma unroll
            for (int m = 0; m < 4; ++m)
#pragma unroll
                for (int n = 0; n < 2; ++n) acc[a][b][m][n] = (f32x4){0.f, 0.f, 0.f, 0.f};
    bf16x8 At[4][2], B0[2][2], B1[2][2];
    const char* cA = (const char*)g.A + (size_t)cur.pm * tstepA; const char* cB = (const char*)g.Bt + (size_t)cur.pn * tstepB;
    S.a_ready(cur);
    if constexpr (SP2) {
        PG8_STAGE(PG8_SB(0, 0), cB, voffB); PG8_STAGE(PG8_SB(0, 1), cB + hstepB, voffB); PG8_STAGE(PG8_SA(0, 0), cA, voffA); PG8_STAGE(PG8_SA(0, 1), cA + hstepA, voffA);
        if (wr == 1) PG8_BAR;
        PG8_WAIT_V(2); PG8_BAR;
        PG8_STAGE(PG8_SB(1, 0), cB + kstep, voffB); PG8_STAGE(PG8_SA(1, 0), cA + kstep, voffA); PG8_STAGE(PG8_SB(1, 1), cB + hstepB + kstep, voffB);
        PG8_WAIT_V(6); PG8_BAR;
    } else {
        PG8_STAGE(PG8_SB(0, 0), cB, voffB); PG8_STAGE(PG8_SA(0, 0), cA, voffA); PG8_STAGE(PG8_SB(0, 1), cB + hstepB, voffB); PG8_STAGE(PG8_SA(0, 1), cA + hstepA, voffA);
        if (wr == 1) PG8_BAR;
        PG8_WAIT_V(4); PG8_BAR;
        PG8_STAGE(PG8_SB(1, 0), cB + kstep, voffB); PG8_STAGE(PG8_SA(1, 0), cA + kstep, voffA); PG8_STAGE(PG8_SB(1, 1), cB + hstepB + kstep, voffB);
        PG8_WAIT_V(6); PG8_BAR;
    }
    for (;;) {
        const bool has_next = S.next(ui + 1, nxt);
        const char* nA = has_next ? (const char*)g.A + (size_t)nxt.pm * tstepA : cA; const char* nB = has_next ? (const char*)g.Bt + (size_t)nxt.pn * tstepB : cB;
        for (int t = 0; t < nt; t += 2) {
            const bool last = (t == nt - 2);
            const char* a1 = cA + (size_t)(t + 1) * kstep;
            const char* a2 = last ? nA : cA + (size_t)(t + 2) * kstep; const char* b2 = last ? nB : cB + (size_t)(t + 2) * kstep;
            const char* a3 = a2 + kstep; const char* b3 = b2 + kstep;
            if (last && has_next) S.a_ready(nxt);
            if constexpr (SP2) {
            PG8_LDB(B0, 0, 0); PG8_LDB(B1, 0, 1); PG8_SCHED; PG8_LDA(At, 0, 0); PG8_STAGE(PG8_SA(1, 1), a1 + hstepA, voffA);
            PG8_WAIT_V(8); PG8_WAIT_L(0); PG8_BAR; PG8_MMA(0, 0, At, B0); PG8_MMA(0, 1, At, B1); PG8_BAR; PG8_SCHED;
            PG8_LDA(At, 0, 1); PG8_STAGE(PG8_SB(0, 0), b2, voffB); PG8_STAGE(PG8_SB(0, 1), b2 + hstepB, voffB); PG8_STAGE(PG8_SA(0, 0), a2, voffA);
            PG8_WAIT_V(8); PG8_WAIT_L(0); PG8_BAR; PG8_MMA(1, 0, At, B0); PG8_MMA(1, 1, At, B1); PG8_BAR; PG8_SCHED;
            PG8_LDB(B0, 1, 0); PG8_LDB(B1, 1, 1); PG8_SCHED; PG8_LDA(At, 1, 0); PG8_STAGE(PG8_SA(0, 1), a2 + hstepA, voffA);
            PG8_WAIT_V(8); PG8_WAIT_L(0); PG8_BAR; PG8_MMA(0, 0, At, B0); PG8_MMA(0, 1, At, B1); PG8_BAR; PG8_SCHED;
            PG8_LDA(At, 1, 1); PG8_STAGE(PG8_SB(1, 0), b3, voffB); PG8_STAGE(PG8_SB(1, 1), b3 + hstepB, voffB); PG8_STAGE(PG8_SA(1, 0), a3, voffA);
            PG8_WAIT_V(8); PG8_WAIT_L(0); PG8_BAR; PG8_MMA(1, 0, At, B0); PG8_MMA(1, 1, At, B1); PG8_BAR; PG8_SCHED;
            } else {
            PG8_LDB(B0, 0, 0); PG8_SCHED; PG8_LDA(At, 0, 0); PG8_STAGE(PG8_SA(1, 1), a1 + hstepA, voffA);
            PG8_WAIT_L(8); PG8_BAR; PG8_WAIT_L(0); PG8_MMA(0, 0, At, B0); PG8_BAR; PG8_SCHED;
            PG8_LDB(B1, 0, 1); PG8_STAGE(PG8_SB(0, 0), b2, voffB);
            PG8_BAR; PG8_WAIT_L(0); PG8_MMA(0, 1, At, B1); PG8_BAR;
            PG8_LDA(At, 0, 1); PG8_STAGE(PG8_SA(0, 0), a2, voffA);
            PG8_BAR; PG8_WAIT_L(0); PG8_MMA(1, 0, At, B0); PG8_BAR; PG8_SCHED;
            PG8_STAGE(PG8_SB(0, 1), b2 + hstepB, voffB);
            PG8_WAIT_V(6); PG8_BAR; PG8_MMA(1, 1, At, B1); PG8_BAR;
            PG8_LDB(B0, 1, 0); PG8_SCHED; PG8_LDA(At, 1, 0); PG8_STAGE(PG8_SA(0, 1), a2 + hstepA, voffA);
            PG8_WAIT_L(8); PG8_BAR; PG8_WAIT_L(0); PG8_MMA(0, 0, At, B0); PG8_BAR; PG8_SCHED;
            PG8_LDB(B1, 1, 1); PG8_STAGE(PG8_SB(1, 0), b3, voffB);
            PG8_BAR; PG8_WAIT_L(0); PG8_MMA(0, 1, At, B1); PG8_BAR;
            PG8_LDA(At, 1, 1); PG8_STAGE(PG8_SA(1, 0), a3, voffA);
            PG8_BAR; PG8_WAIT_L(0); PG8_MMA(1, 0, At, B0); PG8_BAR; PG8_SCHED;
            PG8_STAGE(PG8_SB(1, 1), b3 + hstepB, voffB);
            PG8_WAIT_V(6); PG8_BAR; PG8_MMA(1, 1, At, B1); PG8_BAR;
            }
        }
        if constexpr (ALIGN_EPI) { if (wr == 0) PG8_BAR; }
        if constexpr (!Epi::AFTER_DRAIN) { E(acc, cur, wr, wc, fr, fq); S.done(cur); }
        if (!has_next) break;
#pragma unroll
        for (int a = 0; a < 2; ++a)
#pragma unroll
            for (int b = 0; b < 2; ++b)
#pragma unroll
                for (int m = 0; m < 4; ++m)
#pragma unroll
                    for (int n = 0; n < 2; ++n) acc[a][b][m][n] = (f32x4){0.f, 0.f, 0.f, 0.f};
        cur = nxt; cA = nA; cB = nB; ++ui;
        if constexpr (ALIGN_EPI) { if (wr == 1) PG8_BAR; }
    }
    PG8_WAIT_V(0);
    if constexpr (!ALIGN_EPI) { if (wr == 0) PG8_BAR; }
    PG8_BAR;
    if constexpr (Epi::AFTER_DRAIN) { E.fused(acc, cur, wr, wc, fr, fq, lds, wid, lane); S.done(cur); }
#undef PG8_SA
#undef PG8_SB
#undef PG8_STAGE
#undef PG8_LDA
#undef PG8_LDB
#undef PG8_MMA
#undef PG8_WAIT_V
#undef PG8_WAIT_L
#undef PG8_BAR
#undef PG8_SCHED
}
}

#define GAS __attribute__((address_space(1)))
#define LAS __attribute__((address_space(3)))
typedef unsigned short bf16;
typedef unsigned v4u __attribute__((ext_vector_type(4)));
typedef float f32x4 __attribute__((ext_vector_type(4)));
typedef short bf16x8 __attribute__((ext_vector_type(8)));
typedef GAS unsigned gu32;
typedef GAS unsigned long long gu64;
#define RLX_AGENT __ATOMIC_RELAXED, __HIP_MEMORY_SCOPE_AGENT
#define LDS_WAIT() asm volatile("s_waitcnt lgkmcnt(0)" ::: "memory")
#define VM_WAIT() asm volatile("s_waitcnt vmcnt(0)" ::: "memory")
__device__ __forceinline__ unsigned long long rt() { return __builtin_amdgcn_s_memrealtime(); }
__device__ __forceinline__ unsigned f2bf(float f) { unsigned u = __builtin_bit_cast(unsigned, f); return (u + 0x7fffu + ((u >> 16) & 1u)) >> 16; }
__device__ __forceinline__ unsigned pk2(float lo, float hi) { return f2bf(lo) | (f2bf(hi) << 16); }

#define XB_TMO      128
#define XB_XCNT(j)  (256  + 64 * (j))
#define XB_XSUB(j)  (1280 + 64 * (j))
#define XB_XGEN(j)  (2304 + 64 * (j))
#define XB_TOP      3328
#define XB_TOPGEN   3392
#define XCD_BAR_WORDS 3456
#define XB_SPIN_CAP (1u << 18)

__device__ __forceinline__ unsigned xb_ld(unsigned* p)              { return __hip_atomic_load(p, __ATOMIC_RELAXED, __HIP_MEMORY_SCOPE_AGENT); }
__device__ __forceinline__ unsigned xb_add(unsigned* p, unsigned v) { return __hip_atomic_fetch_add(p, v, __ATOMIC_RELAXED, __HIP_MEMORY_SCOPE_AGENT); }
__device__ __forceinline__ unsigned xb_xcc_id() { return (unsigned)__builtin_amdgcn_s_getreg((3 << 11) | 20) & 0xFu; }
#define XB_SPIN(cond, bar) do { unsigned _sp = 0; while (cond) { __builtin_amdgcn_s_sleep(1); \
    if ((++_sp & 255u) == 0u) { if (xb_ld(&(bar)[XB_TMO])) break; if (_sp > XB_SPIN_CAP) { atomicAdd(&(bar)[XB_TMO], 1u); break; } } } } while (0)

struct XcdBarrier {
    unsigned* bar; unsigned x;
    volatile LAS unsigned* st;
};

__device__ __forceinline__ XcdBarrier xcd_barrier_post(unsigned* bar, volatile LAS unsigned* st) {
    XcdBarrier b; b.bar = bar; b.x = xb_xcc_id(); b.st = st;
    if (threadIdx.x == 0) (void)xb_add(&bar[XB_XCNT(b.x)], 1u);
    return b;
}
__device__ __forceinline__ void xcd_barrier_complete(unsigned* bar, unsigned x, unsigned& nloc, unsigned& nx) {
    const unsigned G = gridDim.x * gridDim.y * gridDim.z;
    unsigned sum, cnt, mine, sp = 0u;
    for (;;) {
        sum = 0u; cnt = 0u; mine = 0u;
#pragma unroll
        for (unsigned j = 0; j < 16; ++j) { const unsigned c = xb_ld(&bar[XB_XCNT(j)]); sum += c; cnt += (c > 0u) ? 1u : 0u; mine = (j == x) ? c : mine; }
        if (sum == G) break;
        __builtin_amdgcn_s_sleep(1);
        if ((++sp & 255u) == 0u) { if (xb_ld(&bar[XB_TMO])) break; if (sp > XB_SPIN_CAP) { atomicAdd(&bar[XB_TMO], 1u); break; } }
    }
    nloc = mine > 0u ? mine : 1u; nx = cnt > 0u ? cnt : 1u;
}

__device__ __forceinline__ void xcd_barrier(const XcdBarrier& b) {
    asm volatile("s_waitcnt vmcnt(0)" ::: "memory");
    __syncthreads();
    if (threadIdx.x == 0) {
        unsigned* bar = b.bar;
        __builtin_amdgcn_s_waitcnt(0);
        unsigned nloc = b.st[0], nx = b.st[1];
        if (nloc == 0u) { xcd_barrier_complete(bar, b.x, nloc, nx); b.st[0] = nloc; b.st[1] = nx; }
        const unsigned old = xb_add(&bar[XB_XSUB(b.x)], 1u);
        const unsigned gen = old / nloc;
        if (old + 1u == (gen + 1u) * nloc) {
            __builtin_amdgcn_fence(__ATOMIC_RELEASE, "agent");
            asm volatile("s_waitcnt vmcnt(0)" ::: "memory");
            const unsigned og = xb_add(&bar[XB_TOP], 1u);
            const unsigned tg = og / nx;
            if (og + 1u == (tg + 1u) * nx) xb_add(&bar[XB_TOPGEN], 1u);
            else XB_SPIN(xb_ld(&bar[XB_TOPGEN]) == tg, bar);
            __builtin_amdgcn_fence(__ATOMIC_ACQUIRE, "agent");
            xb_add(&bar[XB_XGEN(b.x)], 1u);
            asm volatile("s_waitcnt vmcnt(0)" ::: "memory");
        } else {
            XB_SPIN(xb_ld(&bar[XB_XGEN(b.x)]) == gen, bar);
            __builtin_amdgcn_fence(__ATOMIC_ACQUIRE, "agent");
            asm volatile("s_waitcnt vmcnt(0)" ::: "memory");
        }
    }
    __syncthreads();
}

constexpr int NWAVES = 8;
constexpr int DM = 2048, SEQ = 16384, CTXL = 256, DFF = 5632, NB = 2;
constexpr int TL = NB * SEQ;
constexpr int TC = NB * CTXL;
constexpr int T = TL + TC;
constexpr int NMOD = 9 * DM;
constexpr int NIN = 12096, NPROJ = 6144;
constexpr float EPSN = 1e-6f;
constexpr int PC_RX = 0, PC_RG = 1024, PC_DQ = 2048, PC_DK = 3072, PC_DV = 4096, PC_QC = 5120, PC_KVC = 5632, PC_KR = 5888;
enum { I_X = 0, I_C, I_CTX, I_CCTX, I_WMOD, I_BMOD, I_NORMG, I_WG, I_WU, I_WD, I_WIN, I_CONVW, I_CONVB, I_WA, I_BA, I_WX, I_BX, I_LAM,
       I_QCN, I_KVCN, I_WUQ, I_WUKV, I_QN, I_KN, I_DQN, I_DKN, I_DLAM, I_DON, I_BP, I_WOUT, N_INPUTS };

constexpr size_t MiB = 1u << 20;
constexpr size_t WS_CTL = 0, CTL_ZERO_BYTES = 1 * MiB;
constexpr size_t WS_MOD = 1 * MiB;
constexpr size_t WS_XC = 2 * MiB;
constexpr size_t WS_AGG = 6 * MiB;
constexpr size_t WS_ROPE = 9 * MiB;
constexpr size_t WS_W = 13 * MiB;
constexpr size_t W_GU = 0, W_GU_SZ = (size_t)11264 * 2048 * 2;
constexpr size_t W_D = W_GU + 2 * W_GU_SZ, W_D_SZ = (size_t)2048 * 5632 * 2;
constexpr size_t W_IN = W_D + 2 * W_D_SZ, W_IN_SZ = (size_t)6144 * 2048 * 2;
constexpr size_t W_GT = W_IN + W_IN_SZ;
constexpr size_t W_BP = W_GT + W_IN_SZ, W_BP_SZ = (size_t)2048 * 1024 * 2;
constexpr size_t W_OUT = W_BP + 3 * W_BP_SZ;
constexpr size_t W_UQ = W_OUT + (size_t)2048 * 2048 * 2;
constexpr size_t W_UKV = W_UQ + (size_t)1536 * 512 * 2;
constexpr size_t W_LRU = W_UKV + (size_t)2048 * 256 * 2;
constexpr size_t W_END = W_LRU + (size_t)32 * 128 * 128 * 2;
static_assert(W_END <= 204 * MiB, "weights");
constexpr size_t WS_H = WS_W + 204 * MiB;
constexpr size_t WS_PROJ = WS_H + 130 * MiB;
constexpr size_t WS_QRAW = WS_PROJ + 390 * MiB;
constexpr size_t WS_KVRAW = WS_QRAW + 98 * MiB;
constexpr size_t WS_KN = WS_KVRAW + 130 * MiB;
constexpr size_t WS_O12 = WS_KN + 98 * MiB;
constexpr size_t WS_GATES = WS_QRAW;
constexpr size_t WS_BB = WS_O12 + 130 * MiB;
constexpr size_t WS_WAGG = WS_BB + 65 * MiB;
constexpr size_t WS_END = WS_WAGG + 18 * MiB;
static_assert(WS_GATES + 390 * MiB <= WS_BB, "gates overlay");
constexpr int CW_TMO = 0, CW_CODE = 1, CW_BAR = 4096;

constexpr int RING_OFF = 0, RING_BYTES = 131072;
constexpr int LDSCTL_OFF = RING_BYTES, MISC_OFF = LDSCTL_OFF + 320;
constexpr int LDS_BYTES = 147456;
struct Args { const float* in[N_INPUTS]; float* out; unsigned char* ws; int ph_lo, ph_hi; };
struct Frame {
    LAS unsigned char* lds;
    volatile LAS unsigned* MISC;
    gu32* ctl;
    int tid, lane, wave, G;
};
__device__ __forceinline__ float wave_sum(float v) {
#pragma unroll
    for (int o = 1; o < 64; o <<= 1) v += __shfl_xor(v, o);
    return v;
}
__device__ __forceinline__ void transpose_item(const float* W, int ldw, bf16* WT, int ldt, int k0, int n0, int drow0, LAS float* scr, int lane) {
#pragma unroll 8
    for (int i = 0; i < 32; ++i) { const int kk = 2 * i + (lane >> 5); scr[kk * 33 + (lane & 31)] = W[(size_t)(k0 + kk) * ldw + n0 + (lane & 31)]; }
    LDS_WAIT(); asm volatile("" ::: "memory");
    const int c = lane & 7;
#pragma unroll
    for (int j = 0; j < 4; ++j) { const int n = (lane >> 3) + 8 * j; const LAS float* s = scr + (8 * c) * 33 + n;
        v4u o; o.x = pk2(s[0 * 33], s[1 * 33]); o.y = pk2(s[2 * 33], s[3 * 33]); o.z = pk2(s[4 * 33], s[5 * 33]); o.w = pk2(s[6 * 33], s[7 * 33]);
        *(GAS v4u*)(WT + (size_t)(drow0 + n) * ldt + k0 + 8 * c) = o; }
    LDS_WAIT(); asm volatile("" ::: "memory");
}
__device__ __forceinline__ int win_map(int n0) {
    if (n0 < 2048) return n0;
    if (n0 < 2560) return PC_QC + (n0 - 2048);
    if (n0 < 2816) return PC_KVC + (n0 - 2560);
    if (n0 < 2880) return PC_KR + (n0 - 2816);
    if (n0 < 3904) return PC_DQ + (n0 - 2880);
    if (n0 < 4928) return PC_DK + (n0 - 3904);
    return PC_DV + (n0 - 4928);
}
__device__ __forceinline__ void conv_phase(Frame& F, const Args& a, int l) {
    LAS float* scr = (LAS float*)(F.lds + RING_OFF + F.wave * 16384);
    unsigned char* wb = a.ws + WS_W;
    const int gw = blockIdx.x * NWAVES + F.wave, NGW = F.G * NWAVES;
    constexpr int I_GU = (DM / 64) * (DFF / 32);
    constexpr int I_DN = (DFF / 64) * (DM / 32);
    constexpr int I_IN = (DM / 64) * (NIN / 32);
    constexpr int I_BPJ = (1024 / 64) * (DM / 32);
    constexpr int I_WO = (DM / 64) * (DM / 32);
    constexpr int I_UQ = (512 / 64) * (1536 / 32);
    constexpr int I_UKV = (256 / 64) * (2048 / 32);
    constexpr int I_LRU = 32 * 8;
    constexpr int NITEMS = 4 * I_GU + 2 * I_DN + I_IN + 3 * I_BPJ + I_WO + I_UQ + I_UKV + I_LRU;
    for (int it = gw; it < NITEMS; it += NGW) {
        int r = it;
        if (r < 4 * I_GU) { const int mat = r / I_GU, s = mat & 1, isup = mat >> 1; r -= mat * I_GU; const int nblk = DFF / 32, k0 = 64 * (r / nblk), n0 = 32 * (r % nblk);
            const float* W = a.in[isup ? I_WU : I_WG] + (size_t)(l * 2 + s) * DM * DFF;
            transpose_item(W, DFF, (bf16*)(wb + W_GU + s * W_GU_SZ), DM, k0, n0, (n0 >> 7) * 256 + (n0 & 127) + isup * 128, scr, F.lane); continue; }
        r -= 4 * I_GU;
        if (r < 2 * I_DN) { const int s = r / I_DN; r -= s * I_DN; const int nblk = DM / 32, k0 = 64 * (r / nblk), n0 = 32 * (r % nblk);
            transpose_item(a.in[I_WD] + (size_t)(l * 2 + s) * DFF * DM, DM, (bf16*)(wb + W_D + s * W_D_SZ), DFF, k0, n0, n0, scr, F.lane); continue; }
        r -= 2 * I_DN;
        if (r < I_IN) { const int nblk = NIN / 32, k0 = 64 * (r / nblk), n0 = 32 * (r % nblk);
            const bool gt = n0 >= 5952;
            transpose_item(a.in[I_WIN] + (size_t)l * DM * NIN, NIN, (bf16*)(wb + (gt ? W_GT : W_IN)), DM, k0, n0, gt ? n0 - 5952 : win_map(n0), scr, F.lane); continue; }
        r -= I_IN;
        if (r < 3 * I_BPJ) { const int j = r / I_BPJ; r -= j * I_BPJ; const int nblk = DM / 32, k0 = 64 * (r / nblk), n0 = 32 * (r % nblk);
            transpose_item(a.in[I_BP] + (size_t)(l * 3 + j) * 1024 * DM, DM, (bf16*)(wb + W_BP + j * W_BP_SZ), 1024, k0, n0, n0, scr, F.lane); continue; }
        r -= 3 * I_BPJ;
        if (r < I_WO) { const int nblk = DM / 32, k0 = 64 * (r / nblk), n0 = 32 * (r % nblk);
            transpose_item(a.in[I_WOUT] + (size_t)l * DM * DM, DM, (bf16*)(wb + W_OUT), DM, k0, n0, n0, scr, F.lane); continue; }
        r -= I_WO;
        if (r < I_UQ) { const int nblk = 1536 / 32, k0 = 64 * (r / nblk), n0 = 32 * (r % nblk);
            transpose_item(a.in[I_WUQ] + (size_t)l * 512 * 1536, 1536, (bf16*)(wb + W_UQ), 512, k0, n0, n0, scr, F.lane); continue; }
        r -= I_UQ;
        if (r < I_UKV) { const int nblk = 2048 / 32, k0 = 64 * (r / nblk), n0 = 32 * (r % nblk);
            transpose_item(a.in[I_WUKV] + (size_t)l * 256 * 2048, 2048, (bf16*)(wb + W_UKV), 256, k0, n0, n0, scr, F.lane); continue; }
        r -= I_UKV;
        { const int mi = r >> 3, sub = r & 7, k0 = 64 * (sub >> 2), n0 = 32 * (sub & 3);
          const int d = mi >> 4, mat = (mi >> 3) & 1, blk = mi & 7;
          const float* W = a.in[mat ? I_WX : I_WA] + (size_t)((l * 2 + d) * 8 + blk) * 128 * 128;
          transpose_item(W, 128, (bf16*)(wb + W_LRU) + (size_t)mi * 128 * 128, 128, k0, n0, n0, scr, F.lane); }
    }
}
__device__ __forceinline__ void mod_phase(Frame& F, const Args& a) {
    LAS float* S = (LAS float*)(F.lds + RING_OFF);
    LAS f32x4* red = (LAS f32x4*)(F.lds + RING_OFF + 3 * 2048 * 4);
    for (int i = F.tid; i < 3 * DM; i += NWAVES * 64) { const int r = i / DM, k = i % DM; const float v = r < 2 ? a.in[I_C][r * DM + k] : a.in[I_CCTX][k]; S[i] = v * __builtin_amdgcn_rcpf(1.f + __builtin_amdgcn_exp2f(-1.4426950408889634f * v)); }
    __syncthreads();
    float* MOD = (float*)(a.ws + WS_MOD);
    for (int unit = blockIdx.x; unit < 2 * 72; unit += F.G) {
        const int l = unit / 72, nb = unit % 72;
        const float* W = a.in[I_WMOD] + (size_t)l * DM * NMOD + nb * 256 + F.lane * 4;
        f32x4 a0 = {0.f, 0.f, 0.f, 0.f}, a1 = a0, a2 = a0;
        const int kb = F.wave * 256;
#pragma unroll 8
        for (int k = kb; k < kb + 256; ++k) { const f32x4 w = *(const f32x4*)(W + (size_t)k * NMOD); a0 += w * S[k]; a1 += w * S[DM + k]; a2 += w * S[2 * DM + k]; }
        red[(F.wave * 3 + 0) * 64 + F.lane] = a0; red[(F.wave * 3 + 1) * 64 + F.lane] = a1; red[(F.wave * 3 + 2) * 64 + F.lane] = a2;
        __syncthreads();
        for (int idx = F.tid; idx < 3 * 256; idx += NWAVES * 64) { const int r = idx >> 8, col = idx & 255; float s = a.in[I_BMOD][l * NMOD + nb * 256 + col];
#pragma unroll
            for (int w = 0; w < 8; ++w) s += ((LAS float*)red)[((w * 3 + r) * 64 + (col >> 2)) * 4 + (col & 3)];
            MOD[(size_t)(l * 3 + r) * NMOD + nb * 256 + col] = s; }
        __syncthreads();
    }
}
__device__ __forceinline__ void norm_phase(Frame& F, const Args& a, int l, int s, const float* xl, const float* xc) {
    const int gw = blockIdx.x * NWAVES + F.wave, NGW = F.G * NWAVES;
    const float* g = a.in[I_NORMG] + (size_t)(l * 3 + s) * DM;
    const float* MOD = (const float*)(a.ws + WS_MOD);
    bf16* H = (bf16*)(a.ws + WS_H);
    for (int m = gw; m < T; m += NGW) {
        const float* src = m < TL ? xl + (size_t)m * DM : xc + (size_t)(m - TL) * DM;
        const int mrow = m < SEQ ? 0 : (m < TL ? 1 : 2);
        const float* mp = MOD + (size_t)(l * 3 + mrow) * NMOD + (size_t)(3 * s) * DM;
        const GAS f32x4* xr = (const GAS f32x4*)src + F.lane;
        f32x4 v[8]; float ss = 0.f;
#pragma unroll
        for (int j = 0; j < 8; ++j) { v[j] = xr[64 * j]; ss += (v[j].x * v[j].x + v[j].y * v[j].y) + (v[j].z * v[j].z + v[j].w * v[j].w); }
        const float rstd = 1.0f / sqrtf(wave_sum(ss) * (1.f / DM) + EPSN);
        GAS unsigned long long* o8 = (GAS unsigned long long*)(H + (size_t)m * DM) + F.lane;
#pragma unroll
        for (int j = 0; j < 8; ++j) { const int col = F.lane * 4 + 256 * j;
            const f32x4 gv = *(const f32x4*)(g + col), sc = *(const f32x4*)(mp + col), sh = *(const f32x4*)(mp + DM + col);
            const f32x4 o = v[j] * rstd * gv * (sc + 1.0f) + sh;
            o8[64 * j] = (unsigned long long)pk2(o.x, o.y) | ((unsigned long long)pk2(o.z, o.w) << 32); }
    }
}
using pg8::sigmoid_f; using pg8::silu_f; using pg8::gelu_tanh_f;
typedef float f32x16 __attribute__((ext_vector_type(16)));
typedef float f32x2v __attribute__((ext_vector_type(2)));

__device__ __forceinline__ int crow16(int r, int hi) { return (r & 3) + 8 * (r >> 2) + 4 * hi; }
__device__ __forceinline__ float bfbits2f(unsigned short b) { return __uint_as_float((unsigned)b << 16); }
template <bool PASS2> __device__ __forceinline__ void lru_phase(Frame& F, const Args& a, int l) {
    bf16* PROJ = (bf16*)(a.ws + WS_PROJ);
    float* AGG = (float*)(a.ws + WS_AGG);
    float* WAGG_G = (float*)(a.ws + WS_WAGG);
    const bf16* WL = (const bf16*)(a.ws + WS_W + W_LRU);
    const float* convw = a.in[I_CONVW] + (size_t)l * 4 * 1024;
    const float* convb = a.in[I_CONVB] + (size_t)l * 1024;
    const float* ba = a.in[I_BA] + (size_t)l * 2 * 1024;
    const float* bx = a.in[I_BX] + (size_t)l * 2 * 1024;
    const float* lam = a.in[I_LAM] + (size_t)l * 2 * 1024;
    LAS f32x2v* WAGG = (LAS f32x2v*)(F.lds + RING_OFF);
    LAS float* HW = (LAS float*)(F.lds + RING_OFF + 16384);
    const int lane = F.lane, tok = lane & 31, hi = lane >> 5, wave = F.wave;
    LAS unsigned char* xs = F.lds + RING_OFF + 24576 + wave * 8704;
    for (int unit = blockIdx.x; unit < 130 * 8; unit += F.G) {
        const int pm = unit >> 3, nb = unit & 7;
        const bool isl = pm < 128;
        const int b = isl ? (pm >> 6) : (pm - 128);
        const int jj = isl ? (pm & 63) : 0;
        const int len = isl ? SEQ : CTXL;
        const int pos = (isl ? jj * 256 : 0) + wave * 32 + tok;
        const size_t m = (size_t)pm * 256 + wave * 32 + tok;
        if (PASS2) {
            if (F.tid < 256) {
                const int d = F.tid >> 7, ch = F.tid & 127, cg = nb * 128 + ch;
                const float* ag = AGG + ((size_t)(b * 2 + d) * 65) * 2048 + (size_t)cg * 2;
                float h = 0.f;
                if (isl) {
                    { const f32x2v v = *(const f32x2v*)(ag); h = v.y; }
                    if (d == 0) { for (int j = 0; j < jj; ++j) { const f32x2v v = *(const f32x2v*)(ag + (size_t)(1 + j) * 2048); h = v.x * h + v.y; } }
                    else { for (int j = 63; j > jj; --j) { const f32x2v v = *(const f32x2v*)(ag + (size_t)(1 + j) * 2048); h = v.x * h + v.y; } }
                }
                const float* wg = WAGG_G + ((size_t)(pm * 8) * 2 + d) * 2048 + (size_t)cg * 2;
                if (d == 0) { for (int w = 0; w < 8; ++w) { HW[(d * 8 + w) * 128 + ch] = h; const f32x2v v = *(const f32x2v*)(wg + (size_t)w * 4096); h = v.x * h + v.y; } }
                else { for (int w = 7; w >= 0; --w) { HW[(d * 8 + w) * 128 + ch] = h; const f32x2v v = *(const f32x2v*)(wg + (size_t)w * 4096); h = v.x * h + v.y; } }
            }
            __syncthreads();
        }
        bf16x8 xf[8];
        float tm[4];
#pragma unroll
        for (int j = 0; j < 4; ++j) { const int p = pos + j - 2; tm[j] = (p >= 0 && p < len) ? 1.f : 0.f; }
#pragma unroll
        for (int ks = 0; ks < 8; ++ks) {
            const int c0 = nb * 128 + 16 * ks + 8 * hi;
            float xv[8];
            { const f32x4 b0 = *(const f32x4*)(convb + c0), b1 = *(const f32x4*)(convb + c0 + 4);
              xv[0] = b0.x; xv[1] = b0.y; xv[2] = b0.z; xv[3] = b0.w; xv[4] = b1.x; xv[5] = b1.y; xv[6] = b1.z; xv[7] = b1.w; }
#pragma unroll
            for (int j = 0; j < 4; ++j) {
                const long mm = (long)m + (tm[j] != 0.f ? (j - 2) : 0);
                const v4u raw = *(const v4u*)(PROJ + (size_t)mm * NPROJ + PC_RX + c0);
                const f32x4 w0 = *(const f32x4*)(convw + j * 1024 + c0) * tm[j], w1 = *(const f32x4*)(convw + j * 1024 + c0 + 4) * tm[j];
                xv[0] += w0.x * __uint_as_float(raw.x << 16); xv[1] += w0.y * __uint_as_float(raw.x & 0xffff0000u);
                xv[2] += w0.z * __uint_as_float(raw.y << 16); xv[3] += w0.w * __uint_as_float(raw.y & 0xffff0000u);
                xv[4] += w1.x * __uint_as_float(raw.z << 16); xv[5] += w1.y * __uint_as_float(raw.z & 0xffff0000u);
                xv[6] += w1.z * __uint_as_float(raw.w << 16); xv[7] += w1.w * __uint_as_float(raw.w & 0xffff0000u);
            }
            v4u p; p.x = pk2(xv[0], xv[1]); p.y = pk2(xv[2], xv[3]); p.z = pk2(xv[4], xv[5]); p.w = pk2(xv[6], xv[7]);
            xf[ks] = __builtin_bit_cast(bf16x8, p);
            *(LAS bf16x8*)(xs + tok * 272 + (16 * ks + 8 * hi) * 2) = xf[ks];
            __builtin_amdgcn_sched_barrier(0);
        }
        __builtin_amdgcn_sched_barrier(0);
#pragma unroll 1
        for (int mb = 0; mb < 4; ++mb) {
            const int cb = nb * 128 + 32 * mb;
            float xa[16];
#pragma unroll
            for (int g = 0; g < 4; ++g) {
                const unsigned long long raw = *(const LAS unsigned long long*)(xs + tok * 272 + (32 * mb + 8 * g + 4 * hi) * 2);
                const unsigned lo32 = (unsigned)raw, hi32 = (unsigned)(raw >> 32);
                xa[4 * g + 0] = __uint_as_float(lo32 << 16); xa[4 * g + 1] = __uint_as_float(lo32 & 0xffff0000u);
                xa[4 * g + 2] = __uint_as_float(hi32 << 16); xa[4 * g + 3] = __uint_as_float(hi32 & 0xffff0000u); }
            float hsum[16];
#pragma unroll
            for (int e = 0; e < 16; ++e) hsum[e] = 0.f;
#pragma unroll
            for (int d = 0; d < 2; ++d) {
                __builtin_amdgcn_sched_barrier(0);
                f32x16 ar = {}, ai = {};
                const bf16* wra = WL + ((size_t)((d * 2 + 0) * 8 + nb) * 128 + 32 * mb + tok) * 128 + 8 * hi;
                const bf16* wri = WL + ((size_t)((d * 2 + 1) * 8 + nb) * 128 + 32 * mb + tok) * 128 + 8 * hi;
#pragma unroll
                for (int ks = 0; ks < 8; ++ks) {
                    const bf16x8 fa = *(const bf16x8*)(wra + 16 * ks), fi = *(const bf16x8*)(wri + 16 * ks);
                    ar = __builtin_amdgcn_mfma_f32_32x32x16_bf16(fa, xf[ks], ar, 0, 0, 0);
                    ai = __builtin_amdgcn_mfma_f32_32x32x16_bf16(fi, xf[ks], ai, 0, 0, 0);
                }
                __builtin_amdgcn_sched_barrier(0);
                float ca[16], cu[16];
#pragma unroll
                for (int g = 0; g < 4; ++g) { const int c0 = cb + 8 * g + 4 * hi;
                    const f32x4 vba = *(const f32x4*)(ba + d * 1024 + c0), vbx = *(const f32x4*)(bx + d * 1024 + c0), vl = *(const f32x4*)(lam + d * 1024 + c0);
#pragma unroll
                    for (int i = 0; i < 4; ++i) { const int e = 4 * g + i;
                        const float r = sigmoid_f(ar[e] + vba[i]), ig = sigmoid_f(ai[e] + vbx[i]);
                        const float sp = log1pf(__expf(-vl[i]));
                        const float la2 = -8.f * r * sp * 1.4426950408889634f;
                        const float av = __builtin_amdgcn_exp2f(la2);
                        ca[e] = av; cu[e] = sqrtf(fmaxf(1.f - __builtin_amdgcn_exp2f(2.f * la2), 0.f)) * (ig * xa[e]); }
                }
                __builtin_amdgcn_sched_barrier(0);
#pragma unroll
                for (int st = 1; st < 32; st <<= 1) {
                    const bool ok = d == 0 ? (tok >= st) : (tok + st < 32);
#pragma unroll
                    for (int e = 0; e < 16; ++e) {
                        const float pa = d == 0 ? __shfl_up(ca[e], st, 32) : __shfl_down(ca[e], st, 32);
                        const float pu = d == 0 ? __shfl_up(cu[e], st, 32) : __shfl_down(cu[e], st, 32);
                        if (ok) { cu[e] = ca[e] * pu + cu[e]; ca[e] = ca[e] * pa; }
                    }
                }
                __builtin_amdgcn_sched_barrier(0);
                if (!PASS2) {
                    if (tok == (d == 0 ? 31 : 0)) {
                        float* wg = WAGG_G + ((size_t)(pm * 8 + wave) * 2 + d) * 2048;
#pragma unroll
                        for (int e = 0; e < 16; ++e) { const int ch = 32 * mb + crow16(e, hi); const f32x2v v = {ca[e], cu[e]};
                            WAGG[(d * 8 + wave) * 128 + ch] = v; *(f32x2v*)(wg + (size_t)(nb * 128 + ch) * 2) = v; }
                    }
                } else {
#pragma unroll
                    for (int e = 0; e < 16; ++e) { const float hin = HW[(d * 8 + wave) * 128 + 32 * mb + crow16(e, hi)]; hsum[e] += ca[e] * hin + cu[e]; }
                }
            }
            if (PASS2) {
#pragma unroll
                for (int g = 0; g < 4; ++g) { const int c0 = cb + 8 * g + 4 * hi;
                    unsigned long long* p = (unsigned long long*)(PROJ + m * NPROJ + PC_RG + c0);
                    const unsigned long long raw = *p; const unsigned lo32 = (unsigned)raw, hi32 = (unsigned)(raw >> 32);
                    const float y0 = hsum[4 * g + 0] * __uint_as_float(lo32 << 16), y1 = hsum[4 * g + 1] * __uint_as_float(lo32 & 0xffff0000u);
                    const float y2 = hsum[4 * g + 2] * __uint_as_float(hi32 << 16), y3 = hsum[4 * g + 3] * __uint_as_float(hi32 & 0xffff0000u);
                    *p = (unsigned long long)pk2(y0, y1) | ((unsigned long long)pk2(y2, y3) << 32); }
            }
        }
        if (!PASS2) {
            __syncthreads();
            if (F.tid < 256) {
                const int d = F.tid >> 7, ch = F.tid & 127;
                float A = 1.f, U = 0.f;
                if (d == 0) { for (int w = 0; w < 8; ++w) { const f32x2v v = WAGG[(d * 8 + w) * 128 + ch]; U = v.x * U + v.y; A = A * v.x; } }
                else { for (int w = 7; w >= 0; --w) { const f32x2v v = WAGG[(d * 8 + w) * 128 + ch]; U = v.x * U + v.y; A = A * v.x; } }
                const int ci = isl ? 1 + jj : 0;
                *(f32x2v*)(AGG + ((size_t)(b * 2 + d) * 65 + ci) * 2048 + (size_t)(nb * 128 + ch) * 2) = (f32x2v){A, U};
            }
        }
        __syncthreads();
    }
}
namespace att {
using bf16x8 = __attribute__((ext_vector_type(8))) short;
using s16x4  = __attribute__((ext_vector_type(4))) short;
using f32x16 = __attribute__((ext_vector_type(16))) float;
using u32x4  = __attribute__((ext_vector_type(4))) unsigned;
constexpr int QBLK = 32, KVBLK = 64, NW = 8;
constexpr float THR = 8.f;
#define ATT_SBAR() __builtin_amdgcn_sched_barrier(0)
__device__ __forceinline__ int crow(int r, int hi) { return (r & 3) + 8 * (r >> 2) + 4 * hi; }
__device__ __forceinline__ unsigned cvtpk(float lo, float hi) { return pg8::cvt_pk_bf16(lo, hi); }
__device__ __forceinline__ void partialSM(f32x16& p0, f32x16& p1, float& m_reg, float& mn, float& alpha) {
  float pmax = p0[0];
#pragma unroll
  for (int r = 1; r < 16; ++r) pmax = fmaxf(pmax, p0[r]);
#pragma unroll
  for (int r = 0; r < 16; ++r) pmax = fmaxf(pmax, p1[r]);
  { auto rr = __builtin_amdgcn_permlane32_swap(__float_as_uint(pmax), __float_as_uint(pmax), false, false);
    pmax = fmaxf(__uint_as_float(rr[0]), __uint_as_float(rr[1])); }
  if (__builtin_expect(__all(pmax - m_reg <= THR), 1)) { mn = m_reg; alpha = 1.f; }
  else { mn = fmaxf(m_reg, pmax); alpha = __builtin_amdgcn_exp2f(m_reg - mn); m_reg = mn; }
#pragma unroll
  for (int r = 0; r < 16; ++r) p0[r] = p0[r] - mn;
#pragma unroll
  for (int r = 0; r < 16; ++r) p1[r] = p1[r] - mn;
#pragma unroll
  for (int r = 0; r < 16; ++r) p0[r] = __builtin_amdgcn_exp2f(p0[r]);
}
__device__ __forceinline__ void finishSM(f32x16& p0, f32x16& p1, float alpha, float& l_reg, bf16x8& pa0, bf16x8& pa1, bf16x8& pa2, bf16x8& pa3) {
#pragma unroll
  for (int r = 0; r < 16; ++r) p1[r] = __builtin_amdgcn_exp2f(p1[r]);
  float ps = 0;
#pragma unroll
  for (int r = 0; r < 16; ++r) ps += p0[r];
#pragma unroll
  for (int r = 0; r < 16; ++r) ps += p1[r];
  { auto rr = __builtin_amdgcn_permlane32_swap(__float_as_uint(ps), __float_as_uint(ps), false, false);
    ps = __uint_as_float(rr[0]) + __uint_as_float(rr[1]); }
  l_reg = l_reg * alpha + ps;
#define ATT_PK4(P, BASE, OUT) do { unsigned a0 = cvtpk(P[BASE + 0], P[BASE + 1]), a1 = cvtpk(P[BASE + 2], P[BASE + 3]);   \
    unsigned b0 = cvtpk(P[BASE + 4], P[BASE + 5]), b1 = cvtpk(P[BASE + 6], P[BASE + 7]);                              \
    auto r0 = __builtin_amdgcn_permlane32_swap(a0, b0, false, false); auto r1 = __builtin_amdgcn_permlane32_swap(a1, b1, false, false); \
    u32x4 w = {r0[0], r1[0], r0[1], r1[1]}; OUT = *reinterpret_cast<bf16x8*>(&w); } while (0)
  ATT_PK4(p0, 0, pa0); ATT_PK4(p0, 8, pa1); ATT_PK4(p1, 0, pa2); ATT_PK4(p1, 8, pa3);
#undef ATT_PK4
}
template <int DQK> __device__ __forceinline__ int kswz(int row, int colB) { return row * (DQK * 2) + (colB ^ ((row & 7) << 4)); }
template <int DQK> __device__ __forceinline__ void qkt(f32x16& p0, f32x16& p1, const __attribute__((address_space(3))) unsigned char* Ks, const bf16x8* qr, int r32, int hi) {
  p0 = f32x16{}; p1 = f32x16{};
#pragma unroll
  for (int d0 = 0; d0 < DQK / 16; ++d0) { const int cb = (d0 * 16 + hi * 8) * 2;
    const bf16x8 b0 = *(const __attribute__((address_space(3))) bf16x8*)(Ks + kswz<DQK>(r32, cb));
    const bf16x8 b1 = *(const __attribute__((address_space(3))) bf16x8*)(Ks + kswz<DQK>(32 + r32, cb));
    p0 = __builtin_amdgcn_mfma_f32_32x32x16_bf16(b0, qr[d0], p0, 0, 0, 0);
    p1 = __builtin_amdgcn_mfma_f32_32x32x16_bf16(b1, qr[d0], p1, 0, 0, 0); }
}
__device__ __forceinline__ int v_st(int k, int c) { const int kk = (k & ~0xC) | ((k & 4) << 1) | ((k & 8) >> 1); return ((kk >> 3) * 4 + (c >> 5)) * 512 + ((kk & 7) * 32 + (c & 31)) * 2; }
__device__ __forceinline__ int v_rd_base(int lane) { return ((lane & 3) << 3) | (((lane >> 2) & 3) << 6) | (((lane >> 4) & 1) << 5) | (((lane >> 5) & 1) << 8); }
constexpr int v_rd_off(int d0, int ks, int half) { return d0 * 512 + ks * 4096 + half * 2048; }
template <int OFF> __device__ __forceinline__ s16x4 tr_read(int vb) {
  s16x4 r; asm volatile("ds_read_b64_tr_b16 %0, %1 offset:%2" : "=&v"(r) : "v"(vb), "i"(OFF) : "memory"); return r;
}
template <int D0> __device__ __forceinline__ void pv_one(f32x16& od, int vb, bf16x8 pa0, bf16x8 pa1, bf16x8 pa2, bf16x8 pa3) {
  const s16x4 l0 = tr_read<v_rd_off(D0, 0, 0)>(vb), h0 = tr_read<v_rd_off(D0, 0, 1)>(vb), l1 = tr_read<v_rd_off(D0, 1, 0)>(vb), h1 = tr_read<v_rd_off(D0, 1, 1)>(vb);
  const s16x4 l2 = tr_read<v_rd_off(D0, 2, 0)>(vb), h2 = tr_read<v_rd_off(D0, 2, 1)>(vb), l3 = tr_read<v_rd_off(D0, 3, 0)>(vb), h3 = tr_read<v_rd_off(D0, 3, 1)>(vb);
  asm volatile("s_waitcnt lgkmcnt(0)" ::: "memory"); ATT_SBAR();
#define ATT_PK(L, H) (bf16x8){L[0], L[1], L[2], L[3], H[0], H[1], H[2], H[3]}
  od = __builtin_amdgcn_mfma_f32_32x32x16_bf16(pa0, ATT_PK(l0, h0), od, 0, 0, 0);
  od = __builtin_amdgcn_mfma_f32_32x32x16_bf16(pa1, ATT_PK(l1, h1), od, 0, 0, 0);
  od = __builtin_amdgcn_mfma_f32_32x32x16_bf16(pa2, ATT_PK(l2, h2), od, 0, 0, 0);
  od = __builtin_amdgcn_mfma_f32_32x32x16_bf16(pa3, ATT_PK(l3, h3), od, 0, 0, 0);
#undef ATT_PK
}
__device__ __forceinline__ void pv_d0(f32x16* o, int vb, bf16x8 pa0, bf16x8 pa1, bf16x8 pa2, bf16x8 pa3) {
  pv_one<0>(o[0], vb, pa0, pa1, pa2, pa3); pv_one<1>(o[1], vb, pa0, pa1, pa2, pa3); pv_one<2>(o[2], vb, pa0, pa1, pa2, pa3); pv_one<3>(o[3], vb, pa0, pa1, pa2, pa3);
}
template <int DQK> struct AttnCfg { static constexpr int SHM_V = KVBLK * 128 * 2, SHM_K = KVBLK * DQK * 2, NKB = SHM_K / 8192, SHM = 2 * SHM_V + 2 * SHM_K + NW * 64 * 4; };
typedef __attribute__((address_space(3))) unsigned char* ldsp_t;
template <int DQK>
__device__ __forceinline__ void attn_unit(const bf16* __restrict__ Qb, int ldq, const bf16* __restrict__ Kc, const bf16* __restrict__ Kl, int ldk,
                                          const bf16* __restrict__ Vc, const bf16* __restrict__ Vl, int ldv, bf16* __restrict__ Ob, int ldo, int NT, int nt_c, ldsp_t lds) {
  constexpr int SHM_V = AttnCfg<DQK>::SHM_V, SHM_K = AttnCfg<DQK>::SHM_K, NKB = AttnCfg<DQK>::NKB, NKC = DQK / 16, CPR = DQK / 8;
  const int tid = threadIdx.x, wid = __builtin_amdgcn_readfirstlane(tid >> 6), lane = tid & 63, r32 = lane & 31, hi = lane >> 5;
  const ldsp_t V_lds = lds; const ldsp_t K_lds = lds + 2 * SHM_V;
  __attribute__((address_space(3))) float* ws = (__attribute__((address_space(3))) float*)(lds + 122880) + wid * 64;
  __attribute__((address_space(3))) float* li_l = ws; __attribute__((address_space(3))) float* al_l = ws + 32;
  float m_reg = -1e30f, l_reg = 0; f32x16 o[4] = {}; bf16x8 qr[NKC];
  const bf16* Qw = Qb + (long)(wid * QBLK + r32) * ldq + hi * 8;
#pragma unroll
  for (int d0 = 0; d0 < NKC; ++d0) qr[d0] = *reinterpret_cast<const bf16x8*>(Qw + d0 * 16);
  const int vb0 = (int)(unsigned)(uintptr_t)V_lds + v_rd_base(lane);
  int koff[NKB], voff[2];
#pragma unroll
  for (int i = 0; i < NKB; ++i) { const int s_ = (wid + 8 * i) * 64 + lane, row_ = s_ / CPR, chp_ = s_ % CPR; koff[i] = row_ * ldk + ((chp_ ^ (row_ & 7)) << 3); }
#pragma unroll
  for (int i = 0; i < 2; ++i) { const int s_ = (wid + 8 * i) * 64 + lane, sub_ = s_ >> 5, kk_ = ((sub_ >> 2) << 3) | ((s_ >> 2) & 7), c_ = ((sub_ & 3) << 5) | ((s_ & 3) << 3);
    const int k_ = (kk_ & ~0xC) | ((kk_ & 4) << 1) | ((kk_ & 8) >> 1); voff[i] = k_ * ldv + c_; }
#define ATT_DMA(t, b) do { const int t_ = (t); const bool c_ = t_ < nt_c; const long k0_ = c_ ? (long)t_ * KVBLK : (long)(t_ - nt_c) * KVBLK; \
    const bf16* Kb_ = (c_ ? Kc : Kl) + k0_ * ldk; const bf16* Vb_ = (c_ ? Vc : Vl) + k0_ * ldv; \
    _Pragma("unroll") for (int i_ = 0; i_ < NKB; ++i_) __builtin_amdgcn_global_load_lds((const unsigned*)(Kb_ + koff[i_]), (__attribute__((address_space(3))) unsigned*)(K_lds + (b) * SHM_K + (wid + 8 * i_) * 1024), 16, 0, 0); \
    _Pragma("unroll") for (int i_ = 0; i_ < 2; ++i_) __builtin_amdgcn_global_load_lds((const unsigned*)(Vb_ + voff[i_]), (__attribute__((address_space(3))) unsigned*)(V_lds + (b) * SHM_V + (wid + 8 * i_) * 1024), 16, 0, 0); } while (0)
#define ATT_RESC(a) do { if (__any((a) < 1.f)) { if (hi == 0) al_l[r32] = (a); asm volatile("s_waitcnt lgkmcnt(0)" ::: "memory"); \
    _Pragma("unroll") for (int d = 0; d < 4; ++d) _Pragma("unroll") for (int r = 0; r < 16; ++r) o[d][r] *= al_l[crow(r, hi)]; } } while (0)
  bf16x8 pa0, pa1, pa2, pa3; f32x16 p0, p1; float mn, al;
  ATT_DMA(0, 0);
  asm volatile("s_waitcnt vmcnt(0)" ::: "memory"); __syncthreads();
  for (int j = 0; j < NT; ++j) {
    const int cur = j & 1;
    if (j + 1 < NT) { ATT_DMA(j + 1, cur ^ 1); }
    ATT_SBAR(); qkt<DQK>(p0, p1, K_lds + cur * SHM_K, qr, r32, hi);
    partialSM(p0, p1, m_reg, mn, al); ATT_RESC(al);
    finishSM(p0, p1, al, l_reg, pa0, pa1, pa2, pa3); ATT_SBAR();
    pv_d0(o, vb0 + cur * SHM_V, pa0, pa1, pa2, pa3);
    asm volatile("s_waitcnt vmcnt(0)" ::: "memory"); __syncthreads();
  }
  if (hi == 0) li_l[r32] = l_reg; asm volatile("s_waitcnt lgkmcnt(0)" ::: "memory");
  float rli[16];
#pragma unroll
  for (int r = 0; r < 16; ++r) rli[r] = __builtin_amdgcn_rcpf(li_l[crow(r, hi)]);
  { __attribute__((address_space(3))) unsigned short* stg = (__attribute__((address_space(3))) unsigned short*)(lds) + wid * (32 * 136);
#pragma unroll
    for (int r = 0; r < 16; ++r) { const int orow = crow(r, hi);
#pragma unroll
      for (int d0 = 0; d0 < 4; ++d0) stg[orow * 136 + d0 * 32 + r32] = (unsigned short)(cvtpk(o[d0][r] * rli[r], 0.f) & 0xffffu); }
    asm volatile("s_waitcnt lgkmcnt(0)" ::: "memory");
    bf16* Ow = Ob + (long)(wid * QBLK) * ldo;
#pragma unroll
    for (int i = 0; i < 8; ++i) { const int row = i * 4 + (lane >> 4), ch = lane & 15; const u32x4 v = *(const __attribute__((address_space(3))) u32x4*)(stg + row * 136 + ch * 8); *(u32x4*)(Ow + (long)row * ldo + ch * 8) = v; } }
  __syncthreads();
#undef ATT_DMA
#undef ATT_RESC
}
}
constexpr float LOG2E = 1.4426950408889634f;
__device__ __forceinline__ void rope_table_phase(Frame& F, const Args& a) {
    float* RC = (float*)(a.ws + WS_ROPE); float* RS = RC + SEQ * 32;
    for (int i = blockIdx.x * (NWAVES * 64) + F.tid; i < SEQ * 32; i += F.G * NWAVES * 64) {
        const int t = i >> 5, p = i & 31;
        const float inv = powf(10000.0f, -(float)(p & 15) / 16.0f);
        const float ang = (float)(p < 16 ? (t >> 6) : (t & 63)) * inv;
        RC[i] = cosf(ang); RS[i] = sinf(ang);
    }
}
__device__ __forceinline__ void unpack8(const v4u w, float* x) {
    x[0] = __uint_as_float(w.x << 16); x[1] = __uint_as_float(w.x & 0xffff0000u); x[2] = __uint_as_float(w.y << 16); x[3] = __uint_as_float(w.y & 0xffff0000u);
    x[4] = __uint_as_float(w.z << 16); x[5] = __uint_as_float(w.z & 0xffff0000u); x[6] = __uint_as_float(w.w << 16); x[7] = __uint_as_float(w.w & 0xffff0000u);
}
__device__ __forceinline__ v4u pack8(const float* x) { v4u w; w.x = pk2(x[0], x[1]); w.y = pk2(x[2], x[3]); w.z = pk2(x[4], x[5]); w.w = pk2(x[6], x[7]); return w; }
__device__ __forceinline__ void prep1_phase(Frame& F, const Args& a, int l) {
    bf16* PROJ = (bf16*)(a.ws + WS_PROJ);
    const float* RC = (const float*)(a.ws + WS_ROPE); const float* RS = RC + SEQ * 32;
    const float* gqc = a.in[I_QCN] + l * 512; const float* gkvc = a.in[I_KVCN] + l * 256;
    const float* gdq = a.in[I_DQN] + l * 64; const float* gdk = a.in[I_DKN] + l * 64;
    const int gw = blockIdx.x * NWAVES + F.wave, NGW = F.G * NWAVES, lane = F.lane;
    for (int m = gw; m < T; m += NGW) {
        bf16* row = PROJ + (size_t)m * NPROJ;
        const bool isl = m < TL; const int t = m & (SEQ - 1);
        { float x[8]; unpack8(*(const v4u*)(row + PC_QC + lane * 8), x); float ss = 0.f;
#pragma unroll
          for (int i = 0; i < 8; ++i) ss += x[i] * x[i];
          const float rstd = 1.0f / sqrtf(wave_sum(ss) * (1.f / 512.f) + EPSN);
          const f32x4 g0 = *(const f32x4*)(gqc + lane * 8), g1 = *(const f32x4*)(gqc + lane * 8 + 4);
#pragma unroll
          for (int i = 0; i < 4; ++i) { x[i] = x[i] * rstd * g0[i]; x[4 + i] = x[4 + i] * rstd * g1[i]; }
          *(v4u*)(row + PC_QC + lane * 8) = pack8(x); }
        { const unsigned long long raw = *(const unsigned long long*)(row + PC_KVC + lane * 4); const unsigned lo32 = (unsigned)raw, hi32 = (unsigned)(raw >> 32);
          float x0 = __uint_as_float(lo32 << 16), x1 = __uint_as_float(lo32 & 0xffff0000u), x2 = __uint_as_float(hi32 << 16), x3 = __uint_as_float(hi32 & 0xffff0000u);
          const float rstd = 1.0f / sqrtf(wave_sum(x0 * x0 + x1 * x1 + x2 * x2 + x3 * x3) * (1.f / 256.f) + EPSN);
          const f32x4 g0 = *(const f32x4*)(gkvc + lane * 4);
          *(unsigned long long*)(row + PC_KVC + lane * 4) = (unsigned long long)pk2(x0 * rstd * g0.x, x1 * rstd * g0.y) | ((unsigned long long)pk2(x2 * rstd * g0.z, x3 * rstd * g0.w) << 32); }
        {
            static_assert(PC_DK == PC_DQ + 1024, "dq and dk adjacent");
            bf16* p = row + PC_DQ + lane * 32;
            const bool isq = lane < 32;
            const float* gn = (isq ? gdq : gdk) + (lane & 1) * 32;
            const float osc = isq ? 0.125f * LOG2E : 1.0f;
            float x[32];
#pragma unroll
            for (int c = 0; c < 4; ++c) unpack8(*(const v4u*)(p + c * 8), x + c * 8);
            float ss = 0.f;
#pragma unroll
            for (int i = 0; i < 32; ++i) ss += x[i] * x[i];
            ss += __shfl_xor(ss, 1);
            const float rstd = 1.0f / sqrtf(ss * (1.f / 64.f) + EPSN);
#pragma unroll
            for (int c = 0; c < 8; ++c) { const f32x4 g = *(const f32x4*)(gn + c * 4);
#pragma unroll
                for (int i = 0; i < 4; ++i) x[c * 4 + i] = x[c * 4 + i] * rstd * g[i]; }
            if (isl) {
                const bool second = (lane & 1) != 0;
#pragma unroll
                for (int c = 0; c < 8; ++c) { const f32x4 cs = *(const f32x4*)(RC + (size_t)t * 32 + c * 4), sn = *(const f32x4*)(RS + (size_t)t * 32 + c * 4);
#pragma unroll
                    for (int i = 0; i < 4; ++i) { const float mine = x[c * 4 + i], other = __shfl_xor(mine, 1);
                        x[c * 4 + i] = second ? (other * sn[i] + mine * cs[i]) : (mine * cs[i] - other * sn[i]); } }
            }
#pragma unroll
            for (int i = 0; i < 32; ++i) x[i] *= osc;
#pragma unroll
            for (int c = 0; c < 4; ++c) *(v4u*)(p + c * 8) = pack8(x + c * 8);
        }
    }
}
__device__ __forceinline__ void prep2_phase(Frame& F, const Args& a, int l) {
    bf16* PROJ = (bf16*)(a.ws + WS_PROJ); bf16* QRAW = (bf16*)(a.ws + WS_QRAW); bf16* KVRAW = (bf16*)(a.ws + WS_KVRAW); bf16* KN = (bf16*)(a.ws + WS_KN);
    const float* RC = (const float*)(a.ws + WS_ROPE); const float* RS = RC + SEQ * 32;
    const float* gq = a.in[I_QN] + l * 192; const float* gk = a.in[I_KN] + l * 192;
    const int gw = blockIdx.x * NWAVES + F.wave, NGW = F.G * NWAVES, lane = F.lane, h = lane >> 3, sub = lane & 7;
    const float qsc = 0.07216878364870322f * LOG2E;
    for (int m = gw; m < T; m += NGW) {
        const bool isl = m < TL; const int t = m & (SEQ - 1);
#pragma unroll 1
        for (int w = 0; w < 2; ++w) {
            const bf16* pn = w == 0 ? QRAW + (size_t)m * 1536 + h * 192 + sub * 16 : KVRAW + (size_t)m * 2048 + h * 256 + sub * 16;
            const bf16* pr = w == 0 ? QRAW + (size_t)m * 1536 + h * 192 + 128 + sub * 8 : PROJ + (size_t)m * NPROJ + PC_KR + sub * 8;
            bf16* on = (w == 0 ? QRAW : KN) + (size_t)m * 1536 + h * 192 + sub * 16;
            bf16* orp = (w == 0 ? QRAW : KN) + (size_t)m * 1536 + h * 192 + 128 + sub * 8;
            const float* g = w == 0 ? gq : gk;
            float xn[16], xr[8];
            unpack8(*(const v4u*)(pn), xn); unpack8(*(const v4u*)(pn + 8), xn + 8); unpack8(*(const v4u*)(pr), xr);
            float ss = 0.f;
#pragma unroll
            for (int i = 0; i < 16; ++i) ss += xn[i] * xn[i];
#pragma unroll
            for (int i = 0; i < 8; ++i) ss += xr[i] * xr[i];
            ss += __shfl_xor(ss, 1); ss += __shfl_xor(ss, 2); ss += __shfl_xor(ss, 4);
            const float rstd = 1.0f / sqrtf(ss * (1.f / 192.f) + EPSN);
            const float osc = w == 0 ? qsc : 1.0f;
#pragma unroll
            for (int c = 0; c < 4; ++c) { const f32x4 gv = *(const f32x4*)(g + sub * 16 + c * 4);
#pragma unroll
                for (int i = 0; i < 4; ++i) xn[c * 4 + i] = xn[c * 4 + i] * rstd * gv[i] * osc; }
#pragma unroll
            for (int c = 0; c < 2; ++c) { const f32x4 gv = *(const f32x4*)(g + 128 + sub * 8 + c * 4);
#pragma unroll
                for (int i = 0; i < 4; ++i) xr[c * 4 + i] = xr[c * 4 + i] * rstd * gv[i]; }
            if (isl) {
                const bool second = (sub & 4) != 0; const int pi = (sub & 3) * 8;
#pragma unroll
                for (int c = 0; c < 2; ++c) { const f32x4 cs = *(const f32x4*)(RC + (size_t)t * 32 + pi + c * 4), sn = *(const f32x4*)(RS + (size_t)t * 32 + pi + c * 4);
#pragma unroll
                    for (int i = 0; i < 4; ++i) { const float mine = xr[c * 4 + i], other = __shfl_xor(mine, 4);
                        xr[c * 4 + i] = second ? (other * sn[i] + mine * cs[i]) : (mine * cs[i] - other * sn[i]); } }
            }
#pragma unroll
            for (int i = 0; i < 8; ++i) xr[i] *= osc;
            *(v4u*)(on) = pack8(xn); *(v4u*)(on + 8) = pack8(xn + 8); *(v4u*)(orp) = pack8(xr);
        }
    }
}
__device__ __forceinline__ void dcomb_phase(Frame& F, const Args& a, int l) {
    bf16* PROJ = (bf16*)(a.ws + WS_PROJ); const bf16* O12 = (const bf16*)(a.ws + WS_O12);
    const float* lp = a.in[I_DLAM] + l * 256; const float* go = a.in[I_DON] + l * 128;
    const int gw = blockIdx.x * NWAVES + F.wave, NGW = F.G * NWAVES, lane = F.lane, h = lane >> 3, sub = lane & 7;
    const float lam_init = l == 0 ? 0.2f : (0.8f - 0.6f * 0.7408182206817179f);
    const float s1 = wave_sum(lp[lane] * lp[64 + lane]), s2 = wave_sum(lp[128 + lane] * lp[192 + lane]);
    const float lam = expf(s1) - expf(s2) + lam_init;
    for (int m = gw; m < T; m += NGW) {
        const bf16* p1 = O12 + (size_t)m * 2048 + (2 * h) * 128 + sub * 16; const bf16* p2 = p1 + 128;
        float x1[16], x2[16];
        unpack8(*(const v4u*)(p1), x1); unpack8(*(const v4u*)(p1 + 8), x1 + 8); unpack8(*(const v4u*)(p2), x2); unpack8(*(const v4u*)(p2 + 8), x2 + 8);
        float ss = 0.f;
#pragma unroll
        for (int i = 0; i < 16; ++i) { x1[i] = x1[i] - lam * x2[i]; ss += x1[i] * x1[i]; }
        ss += __shfl_xor(ss, 1); ss += __shfl_xor(ss, 2); ss += __shfl_xor(ss, 4);
        const float rstd = (1.0f / sqrtf(ss * (1.f / 128.f) + EPSN)) * (1.0f - lam_init);
#pragma unroll
        for (int c = 0; c < 4; ++c) { const f32x4 gv = *(const f32x4*)(go + sub * 16 + c * 4);
#pragma unroll
            for (int i = 0; i < 4; ++i) x1[c * 4 + i] = x1[c * 4 + i] * rstd * gv[i]; }
        bf16* o = PROJ + (size_t)m * NPROJ + PC_DQ + h * 128 + sub * 16;
        *(v4u*)(o) = pack8(x1); *(v4u*)(o + 8) = pack8(x1 + 8);
    }
}
__device__ __forceinline__ void attn_phase(Frame& F, const Args& a, int l) {
    const bf16* PROJ = (const bf16*)(a.ws + WS_PROJ); const bf16* QRAW = (const bf16*)(a.ws + WS_QRAW); const bf16* KVRAW = (const bf16*)(a.ws + WS_KVRAW); const bf16* KN = (const bf16*)(a.ws + WS_KN);
    bf16* O12 = (bf16*)(a.ws + WS_O12); bf16* BB = (bf16*)(a.ws + WS_BB);
    const att::ldsp_t lds = (att::ldsp_t)(F.lds + RING_OFF);
    const int NU = 1024 + 2048 + (l == 0 ? 48 : 0);
    for (int u = blockIdx.x; u < NU; u += F.G) {
        if (u < 1024 || (u >= 3072 && u < 3088)) {
            const bool cq = u >= 3072; const int v = cq ? u - 3072 : u;
            const int b = cq ? (v >> 3) : (v >> 9), h = cq ? (v & 7) : ((v >> 6) & 7), qb = cq ? 0 : (v & 63);
            const size_t qrow = cq ? (size_t)TL + b * CTXL : (size_t)b * SEQ + qb * 256, crow0 = (size_t)TL + b * CTXL, lrow0 = (size_t)b * SEQ;
            att::attn_unit<192>(QRAW + qrow * 1536 + h * 192, 1536, KN + crow0 * 1536 + h * 192, KN + lrow0 * 1536 + h * 192, 1536,
                                KVRAW + crow0 * 2048 + h * 256 + 128, KVRAW + lrow0 * 2048 + h * 256 + 128, 2048, BB + qrow * 1024 + h * 128, 1024, cq ? 4 : 260, 4, lds);
        } else {
            const bool cq = u >= 3088; const int v = cq ? u - 3088 : u - 1024;
            const int b = cq ? (v >> 4) : (v >> 10), vh = cq ? (v & 15) : ((v >> 6) & 15), qb = cq ? 0 : (v & 63);
            const size_t qrow = cq ? (size_t)TL + b * CTXL : (size_t)b * SEQ + qb * 256, crow0 = (size_t)TL + b * CTXL, lrow0 = (size_t)b * SEQ;
            att::attn_unit<64>(PROJ + qrow * NPROJ + PC_DQ + vh * 64, NPROJ, PROJ + crow0 * NPROJ + PC_DK + vh * 64, PROJ + lrow0 * NPROJ + PC_DK + vh * 64, NPROJ,
                               PROJ + crow0 * NPROJ + PC_DV + (vh >> 1) * 128, PROJ + lrow0 * NPROJ + PC_DV + (vh >> 1) * 128, NPROJ, O12 + qrow * 2048 + vh * 128, 2048, cq ? 4 : 260, 4, lds);
        }
    }
}
constexpr int NPH = 17;
constexpr int NPHASES = 2 * NPH;
#ifndef PH_LIMIT
#define PH_LIMIT NPHASES
#endif
#if MK_FUSED
#define GRID_BAR() xcd_barrier(bar)
#else
#define GRID_BAR() do {} while (0)
#endif
#define IN(k) (lo <= (k) && (k) < hi)
#define SEAM(k) do { if (IN(k) && IN((k) + 1)) GRID_BAR(); } while (0)
template <int l> __device__ __forceinline__ void layer_phases(Frame& F, const Args& args, const XcdBarrier& bar, const int lo, const int hi) {
    unsigned char* ws = args.ws;
    float* MOD = (float*)(ws + WS_MOD);
    float* XC = (float*)(ws + WS_XC);
    bf16* H = (bf16*)(ws + WS_H);
    bf16* PROJ = (bf16*)(ws + WS_PROJ);
    bf16* AFF = PROJ;
    unsigned char* wb = ws + WS_W;
    const int cid = (int)blockIdx.x;
        const int pb = l * NPH;
        const float* xl_in = l == 0 ? args.in[I_X] : args.out;
        const float* xc_in = l == 0 ? args.in[I_CTX] : XC;
        const float* MODl = MOD + (size_t)l * 3 * NMOD;
        if (IN(pb + 0)) { conv_phase(F, args, l); if (l == 0) { rope_table_phase(F, args); __syncthreads(); mod_phase(F, args); } }
        SEAM(pb + 0);
        if (IN(pb + 1)) norm_phase(F, args, l, 0, xl_in, xc_in);
        SEAM(pb + 1);
        if (IN(pb + 2)) { pg8::Gemm g{H, (const bf16*)(wb + W_GU), T, 2 * DFF, DM, DM, DM}; pg8::StaticOrder S; S.init(T, 2 * DFF, F.G, cid);
            pg8::EpiSwiglu E{AFF, DFF}; pg8::gemm_phase<pg8::EpiSwiglu, pg8::StaticOrder, true, true>(F.lds + RING_OFF, g, S, E); }
        SEAM(pb + 2);
        if (IN(pb + 3)) { pg8::Gemm g{AFF, (const bf16*)(wb + W_D), T, DM, DFF, DFF, DFF}; pg8::StaticOrder S; S.init(T, DM, F.G, cid);
            pg8::EpiResid E{xl_in, xc_in, args.out, XC, MODl + 2 * DM, 0.5f}; pg8::gemm_phase<pg8::EpiResid, pg8::StaticOrder, true, true>(F.lds + RING_OFF, g, S, E); }
        SEAM(pb + 3);
        if (IN(pb + 4)) norm_phase(F, args, l, 1, args.out, XC);
        SEAM(pb + 4);
        if (IN(pb + 5)) { pg8::Gemm g{H, (const bf16*)(wb + W_IN), T, NPROJ, DM, DM, DM}; pg8::StaticOrder S; S.init(T, NPROJ, F.G, cid);
            pg8::EpiAct<1> E{PROJ, NPROJ}; pg8::gemm_phase<pg8::EpiAct<1>, pg8::StaticOrder, true, true>(F.lds + RING_OFF, g, S, E); }
        SEAM(pb + 5);
        if (IN(pb + 6)) { prep1_phase(F, args, l); lru_phase<false>(F, args, l); }
        SEAM(pb + 6);
        if (IN(pb + 7)) {
            { pg8::Gemm g{PROJ + PC_QC, (const bf16*)(wb + W_UQ), T, 1536, 512, NPROJ, 512}; pg8::StaticOrder S; S.init(T, 1536, F.G, cid);
              pg8::EpiAct<0> E{(bf16*)(ws + WS_QRAW), 1536}; pg8::gemm_phase<pg8::EpiAct<0>, pg8::StaticOrder, true, true>(F.lds + RING_OFF, g, S, E); }
            { pg8::Gemm g{PROJ + PC_KVC, (const bf16*)(wb + W_UKV), T, 2048, 256, NPROJ, 256}; pg8::StaticOrder S; S.init(T, 2048, F.G, cid);
              pg8::EpiAct<0> E{(bf16*)(ws + WS_KVRAW), 2048}; pg8::gemm_phase<pg8::EpiAct<0>, pg8::StaticOrder, true, true>(F.lds + RING_OFF, g, S, E); }
            lru_phase<true>(F, args, l);
        }
        SEAM(pb + 7);
        if (IN(pb + 8)) prep2_phase(F, args, l);
        SEAM(pb + 8);
        if (IN(pb + 9)) attn_phase(F, args, l);
        SEAM(pb + 9);
        if (IN(pb + 10)) dcomb_phase(F, args, l);
        SEAM(pb + 10);
        if (IN(pb + 11)) { pg8::Gemm g{H, (const bf16*)(wb + W_GT), T, NPROJ, DM, DM, DM}; pg8::StaticOrder S; S.init(T, NPROJ, F.G, cid);
            pg8::EpiAct<2> E{(bf16*)(ws + WS_GATES), NPROJ}; pg8::gemm_phase<pg8::EpiAct<2>, pg8::StaticOrder, true, true>(F.lds + RING_OFF, g, S, E); }
        SEAM(pb + 11);
        if (IN(pb + 12)) { pg8::StaticOrder S; S.init(T, DM, F.G, cid);
            { pg8::Gemm g{PROJ + PC_RG, (const bf16*)(wb + W_BP), T, DM, 1024, NPROJ, 1024};
              pg8::EpiMerge<0> E{H, (const bf16*)(ws + WS_GATES)}; pg8::gemm_phase<pg8::EpiMerge<0>, pg8::StaticOrder, true, true>(F.lds + RING_OFF, g, S, E); }
            { pg8::Gemm g{(const bf16*)(ws + WS_BB), (const bf16*)(wb + W_BP + W_BP_SZ), T, DM, 1024, 1024, 1024};
              pg8::EpiMerge<1> E{H, (const bf16*)(ws + WS_GATES)}; pg8::gemm_phase<pg8::EpiMerge<1>, pg8::StaticOrder, true, true>(F.lds + RING_OFF, g, S, E); }
            { pg8::Gemm g{PROJ + PC_DQ, (const bf16*)(wb + W_BP + 2 * W_BP_SZ), T, DM, 1024, NPROJ, 1024};
              pg8::EpiMerge<2> E{H, (const bf16*)(ws + WS_GATES)}; pg8::gemm_phase<pg8::EpiMerge<2>, pg8::StaticOrder, true, true>(F.lds + RING_OFF, g, S, E); }
        }
        SEAM(pb + 12);
        if (IN(pb + 13)) { pg8::Gemm g{H, (const bf16*)(wb + W_OUT), T, DM, DM, DM, DM}; pg8::StaticOrder S; S.init(T, DM, F.G, cid);
            pg8::EpiResid E{args.out, XC, args.out, XC, MODl + 5 * DM, 1.0f}; pg8::gemm_phase<pg8::EpiResid, pg8::StaticOrder, true, true>(F.lds + RING_OFF, g, S, E); }
        SEAM(pb + 13);
        if (IN(pb + 14)) norm_phase(F, args, l, 2, args.out, XC);
        SEAM(pb + 14);
        if (IN(pb + 15)) { pg8::Gemm g{H, (const bf16*)(wb + W_GU + W_GU_SZ), T, 2 * DFF, DM, DM, DM}; pg8::StaticOrder S; S.init(T, 2 * DFF, F.G, cid);
            pg8::EpiSwiglu E{AFF, DFF}; pg8::gemm_phase<pg8::EpiSwiglu, pg8::StaticOrder, true, true>(F.lds + RING_OFF, g, S, E); }
        SEAM(pb + 15);
        if (IN(pb + 16)) { pg8::Gemm g{AFF, (const bf16*)(wb + W_D + W_D_SZ), T, DM, DFF, DFF, DFF}; pg8::StaticOrder S; S.init(T, DM, F.G, cid);
            pg8::EpiResid E{args.out, XC, args.out, XC, MODl + 8 * DM, 0.5f}; pg8::gemm_phase<pg8::EpiResid, pg8::StaticOrder, true, true>(F.lds + RING_OFF, g, S, E); }
        SEAM(pb + 16);

    }
#undef IN
#undef SEAM
__global__ void __launch_bounds__(NWAVES * 64, 2) fwd(Args args) {
    extern __shared__ __attribute__((aligned(16))) unsigned char lds[];
    Frame F;
    F.lds = (LAS unsigned char*)lds;
    F.MISC = (volatile LAS unsigned*)(F.lds + MISC_OFF);
    F.tid = threadIdx.x; F.lane = F.tid & 63; F.wave = __builtin_amdgcn_readfirstlane(F.tid >> 6);
    F.G = gridDim.x;
    F.ctl = (gu32*)(args.ws + WS_CTL);
    for (int u = F.tid; u < (LDS_BYTES - LDSCTL_OFF) / 4; u += NWAVES * 64) ((LAS unsigned*)(F.lds + LDSCTL_OFF))[u] = 0u;
    __syncthreads();
#if MK_FUSED
    XcdBarrier bar = xcd_barrier_post((unsigned*)(F.ctl + CW_BAR), F.MISC + 8);
#else
    XcdBarrier bar; bar.bar = nullptr; bar.x = 0; bar.st = nullptr;
#endif
    layer_phases<0>(F, args, bar, args.ph_lo, args.ph_hi);
    layer_phases<1>(F, args, bar, args.ph_lo, args.ph_hi);
}

extern "C" void kernel_launch(void* const* d_in, const int* in_sizes, int n_in, void* d_out, int out_size, void* d_ws, size_t ws_size, hipStream_t stream) {
    static int grid = 0;
    if (grid == 0) {
        if (n_in != N_INPUTS || in_sizes[0] != TL * DM || out_size != TL * DM || ws_size < WS_END) { fprintf(stderr, "kernel_launch: shape/workspace mismatch (n_in %d, ws %zu, need %zu)\n", n_in, ws_size, (size_t)WS_END); grid = -1; return; }
        int dev = 0, cus = 0, per_cu = 0;
        if (hipGetDevice(&dev) != hipSuccess || hipDeviceGetAttribute(&cus, hipDeviceAttributeMultiprocessorCount, dev) != hipSuccess) { grid = -1; return; }
        if (hipFuncSetAttribute((const void*)fwd, hipFuncAttributeMaxDynamicSharedMemorySize, LDS_BYTES) != hipSuccess) { fprintf(stderr, "kernel_launch: hipFuncSetAttribute failed\n"); grid = -1; return; }
        if (hipOccupancyMaxActiveBlocksPerMultiprocessor(&per_cu, (const void*)fwd, NWAVES * 64, LDS_BYTES) != hipSuccess || per_cu < 1) fprintf(stderr, "kernel_launch: occupancy query reports %d\n", per_cu);
        (void)hipGetLastError();
        grid = cus;
    }
    if (grid < 0) return;
    if (hipMemsetAsync((char*)d_ws + WS_CTL, 0, CTL_ZERO_BYTES, stream) != hipSuccess) return;
    Args a{};
    for (int i = 0; i < N_INPUTS; ++i) a.in[i] = (const float*)d_in[i];
    a.out = (float*)d_out; a.ws = (unsigned char*)d_ws;
#if MK_FUSED
    a.ph_lo = 0; a.ph_hi = PH_LIMIT;
    hipLaunchKernelGGL(fwd, dim3(grid), dim3(NWAVES * 64), LDS_BYTES, stream, a);
#else
    for (int ph = 0; ph < PH_LIMIT; ++ph) { a.ph_lo = ph; a.ph_hi = ph + 1; hipLaunchKernelGGL(fwd, dim3(grid), dim3(NWAVES * 64), LDS_BYTES, stream, a); }
#endif
    const hipError_t le = hipPeekAtLastError();
    if (le != hipSuccess) fprintf(stderr, "kernel_launch: launch failed: %s\n", hipGetErrorName(le));
}
```

```cpp
#include <hip/hip_runtime.h>
#include <cstdio>
#include <cstdint>
#ifndef MK_FUSED
#define MK_FUSED 1
#endif
#define PH_LIMIT 34
namespace pg8 {
#define PG8_LAS __attribute__((address_space(3)))
typedef unsigned short bf16_t;
typedef short bf16x8 __attribute__((ext_vector_type(8)));
typedef float f32x4 __attribute__((ext_vector_type(4)));
typedef unsigned u32x4 __attribute__((ext_vector_type(4)));
constexpr int BM = 256, BK = 64, HALF = 128, HTB = HALF * BK * 2  , STAGE_BYTES = 8 * HTB, NXCD = 8, WGM = 8;

__host__ __device__ __forceinline__ int lds_byte(int r, int c) { const int st = (r >> 4) * 2 + (c >> 5), rr = r & 15, cc = c & 31, ob = rr * 64 + cc * 2; return st * 1024 + (ob ^ (((ob >> 9) & 1) << 5)); }
__host__ __device__ __forceinline__ void stage_rc(int b, int& R, int& C) { const int st = b / 1024, sb = b % 1024, swz = sb ^ (((sb >> 9) & 1) << 5); R = (st >> 1) * 16 + swz / 64; C = (st & 1) * 32 + (swz % 64) / 2; }
__host__ __device__ __forceinline__ int perm32(int rho) { const int n = rho >> 4, i = rho & 15; return 8 * (i >> 2) + 4 * n + (i & 3); }

struct Unit { int pm, pn, ks; };
struct Gemm { const bf16_t* A; const bf16_t* Bt; int M, N, K, lda, ldb; };

struct StaticOrder {
    static constexpr int KSL = 0;
    int nM, nN, nwg, G, c;
    __host__ __device__ void init(int M, int N, int G_, int c_) { nM = M / BM; nN = N / BM; nwg = nM * nN; G = G_; c = c_; }
    __host__ __device__ bool next(int i, Unit& u) const {
        const long L = (long)i * G + c; if (L >= nwg) return false;
        int wgid = (int)L; { const int q = nwg / NXCD, r = nwg % NXCD, xcd = wgid % NXCD, off = wgid / NXCD; wgid = (xcd < r ? xcd * (q + 1) : r * (q + 1) + (xcd - r) * q) + off; }
        const int nig = WGM * nN, gid = wgid / nig, fm = gid * WGM, gsz = (nM - fm) < WGM ? (nM - fm) : WGM;
        u.pm = fm + ((wgid % nig) % gsz); u.pn = (wgid % nig) / gsz; u.ks = 0; return true;
    }
    __device__ __forceinline__ size_t a_off(const Unit&) const { return 0; }
    __device__ __forceinline__ size_t b_off(const Unit&) const { return 0; }
    __device__ __forceinline__ void a_ready(const Unit&) const {}
    __device__ __forceinline__ void done(const Unit&) const {}
};

template <int K_, int S_> struct SplitTailOrder {
    static constexpr int KSL = K_ / S_;
    static_assert(K_ % S_ == 0 && KSL % 128 == 0 && KSL >= 256, "slice length: a multiple of 128, >= 256");
    StaticOrder base; int nN, c, G, nreg, nsl;
    __host__ __device__ void init(int Mlat, int N, int nctx, int G_, int c_) { base.init(Mlat, N, G_, c_); nN = N / BM; c = c_; G = G_; nreg = (base.nwg - c_ + G_ - 1) / G_; if (nreg < 0) nreg = 0; nsl = nctx * nN * S_; }
    __host__ __device__ bool next(int i, Unit& u) const {
        if (i < nreg) return base.next(i, u);
        const int s = (i - nreg) * G + c; if (s >= nsl) return false;
        const int tile = s / S_; u.pm = base.nM + tile / nN; u.pn = tile % nN; u.ks = 1 + s % S_; return true;
    }
    __device__ __forceinline__ size_t a_off(const Unit&) const { return 0; }
    __device__ __forceinline__ size_t b_off(const Unit&) const { return 0; }
    __device__ __forceinline__ void a_ready(const Unit&) const {}
    __device__ __forceinline__ void done(const Unit&) const {}
};

template <unsigned A0, unsigned A1, unsigned A2, unsigned BS>
struct MergeOrder {
    static constexpr int KSL = 0;
    StaticOrder base;
    __host__ __device__ void init(int M, int N, int G_, int c_) { base.init(M, N, G_, c_); }
    __host__ __device__ bool next(int i, Unit& u) const { const int q = i / 3; if (!base.next(q, u)) return false; u.ks = i - 3 * q; return true; }
    __device__ __forceinline__ size_t a_off(const Unit& u) const { return u.ks == 0 ? (size_t)A0 : (u.ks == 1 ? (size_t)A1 : (size_t)A2); }
    __device__ __forceinline__ size_t b_off(const Unit& u) const { return (size_t)u.ks * BS; }
    __device__ __forceinline__ void a_ready(const Unit&) const {}
    __device__ __forceinline__ void done(const Unit&) const {}
};

typedef float f32x2_c __attribute__((ext_vector_type(2))); typedef __bf16 bf16x2_c __attribute__((ext_vector_type(2)));
__device__ __forceinline__ unsigned cvt_pk_bf16(float lo, float hi) { f32x2_c v = {lo, hi}; bf16x2_c b = __builtin_convertvector(v, bf16x2_c); return __builtin_bit_cast(unsigned, b); }
typedef float f32x2 __attribute__((ext_vector_type(2)));
__device__ __forceinline__ f32x2 gelu_pk(f32x2 v) {
    const f32x2 av = __builtin_elementwise_abs(v), d = av * 0.2316418882f + 1.0f;
    f32x2 t; t.x = __builtin_amdgcn_rcpf(d.x); t.y = __builtin_amdgcn_rcpf(d.y);
    f32x2 q = t * 0.5307027145f + (-0.7265760135f); q = q * t + 0.7107068705f; q = q * t + (-0.142248368f); q = q * t + 0.127414796f; q = q * t;
    const f32x2 s = (v * v) * (-0.72134752044f);
    f32x2 e; e.x = __builtin_amdgcn_exp2f(s.x); e.y = __builtin_amdgcn_exp2f(s.y);
    const f32x2 m = v * (q * e), r = v - m;
    f32x2 o; o.x = v.x < 0.f ? m.x : r.x; o.y = v.y < 0.f ? m.y : r.y; return o;
}

__device__ __forceinline__ float sigmoid_f(float x) { return __builtin_amdgcn_rcpf(1.f + __builtin_amdgcn_exp2f(-1.4426950408889634f * x)); }
__device__ __forceinline__ float silu_f(float x) { return x * sigmoid_f(x); }
__device__ __forceinline__ float gelu_tanh_f(float x) { const float z = 0.7978845608028654f * (x + 0.044715f * x * x * x); return x * sigmoid_f(2.f * z); }
__device__ __forceinline__ float bf_lo(unsigned w) { return __uint_as_float(w << 16); }
__device__ __forceinline__ float bf_hi(unsigned w) { return __uint_as_float(w & 0xffff0000u); }

struct EpiSwiglu {
    static constexpr bool PERM = true, AFTER_DRAIN = false;
    bf16_t* O; int ldc;
    __device__ __forceinline__ void operator()(const f32x4 (&acc)[2][2][4][2], const Unit& u, int wr, int wc, int fr, int fq) const {
        const int row0 = u.pm * BM + wr * 64 + fr, col0 = u.pn * HALF + wc * 32 + 8 * fq;
#pragma unroll
        for (int ai = 0; ai < 2; ++ai)
#pragma unroll
            for (int m = 0; m < 4; ++m) {
                bf16_t* rowp = O + (size_t)(row0 + ai * HALF + m * 16) * ldc + col0;
                const f32x4 g0 = acc[ai][0][m][0], g1 = acc[ai][0][m][1], u0 = acc[ai][1][m][0], u1 = acc[ai][1][m][1];
                u32x4 w;
                w.x = cvt_pk_bf16(silu_f(g0[0]) * u0[0], silu_f(g0[1]) * u0[1]); w.y = cvt_pk_bf16(silu_f(g0[2]) * u0[2], silu_f(g0[3]) * u0[3]);
                w.z = cvt_pk_bf16(silu_f(g1[0]) * u1[0], silu_f(g1[1]) * u1[1]); w.w = cvt_pk_bf16(silu_f(g1[2]) * u1[2], silu_f(g1[3]) * u1[3]);
                *(u32x4*)rowp = w;
            }
    }
};
struct EpiResid {
    static constexpr bool PERM = false, AFTER_DRAIN = false;
    const float* base_lat; const float* base_ctx; float* out_lat; float* out_ctx; const float* gate; float* part; float gs;
    __device__ __forceinline__ void operator()(const f32x4 (&acc)[2][2][4][2], const Unit& u, int wr, int wc, int fr, int fq) const {
        const bool isl = u.pm < 128;
        const float* base = isl ? base_lat + (size_t)u.pm * BM * 2048 : base_ctx + (size_t)(u.pm - 128) * BM * 2048;
        float* out = isl ? out_lat + (size_t)u.pm * BM * 2048 : out_ctx + (size_t)(u.pm - 128) * BM * 2048;
        const int mrow = u.pm < 64 ? 0 : (u.pm < 128 ? 1 : 2);
        const float* gp = gate + (size_t)mrow * 18432;
        const int col0 = u.pn * BM + wc * 32 + 4 * fq;
        f32x4 gv[2][2];
#pragma unroll
        for (int bj = 0; bj < 2; ++bj)
#pragma unroll
            for (int n = 0; n < 2; ++n) gv[bj][n] = *(const f32x4*)(gp + col0 + bj * HALF + n * 16) * gs;
        if (u.ks != 0) {
            float* pp = part + (size_t)(u.ks - 1) * (512 * 2048) + (size_t)(u.pm - 128) * BM * 2048;
#pragma unroll
            for (int bj = 0; bj < 2; ++bj)
#pragma unroll
                for (int n = 0; n < 2; ++n)
#pragma unroll
                    for (int ai = 0; ai < 2; ++ai)
#pragma unroll
                        for (int m = 0; m < 4; ++m) {
                            const size_t off = (size_t)(ai * HALF + wr * 64 + m * 16 + fr) * 2048 + col0 + bj * HALF + n * 16;
                            *(f32x4*)(pp + off) = gv[bj][n] * acc[ai][bj][m][n]; }
        } else {
#pragma unroll
            for (int bj = 0; bj < 2; ++bj)
#pragma unroll
              for (int n = 0; n < 2; ++n) {
                f32x4 b[2][4];
#pragma unroll
                for (int ai = 0; ai < 2; ++ai)
#pragma unroll
                    for (int m = 0; m < 4; ++m) b[ai][m] = *(const f32x4*)(base + (size_t)(ai * HALF + wr * 64 + m * 16 + fr) * 2048 + col0 + bj * HALF + n * 16);
#pragma unroll
                for (int ai = 0; ai < 2; ++ai)
#pragma unroll
                    for (int m = 0; m < 4; ++m)
                        *(f32x4*)(out + (size_t)(ai * HALF + wr * 64 + m * 16 + fr) * 2048 + col0 + bj * HALF + n * 16) = b[ai][m] + gv[bj][n] * acc[ai][bj][m][n];
              }
        }
    }
};
template <int ACT> struct EpiAct {
    static constexpr bool PERM = true, AFTER_DRAIN = false;
    bf16_t* O; int ldc;
    __device__ __forceinline__ void operator()(const f32x4 (&acc)[2][2][4][2], const Unit& u, int wr, int wc, int fr, int fq) const {
        const int row0 = u.pm * BM + wr * 64 + fr, col0 = u.pn * BM + wc * 32 + 8 * fq;
        const bool dog = (ACT == 1) && (u.pn >= 4 && u.pn < 8);
#pragma unroll
        for (int ai = 0; ai < 2; ++ai)
#pragma unroll
            for (int m = 0; m < 4; ++m) {
                bf16_t* rowp = O + (size_t)(row0 + ai * HALF + m * 16) * ldc + col0;
#pragma unroll
                for (int bj = 0; bj < 2; ++bj) {
                    f32x4 v0 = acc[ai][bj][m][0], v1 = acc[ai][bj][m][1];
                    if (ACT == 1) { if (dog) {
#pragma unroll
                        for (int j = 0; j < 4; ++j) { v0[j] = gelu_tanh_f(v0[j]); v1[j] = gelu_tanh_f(v1[j]); } } }
                    if (ACT == 2) {
#pragma unroll
                        for (int j = 0; j < 4; ++j) { v0[j] = sigmoid_f(v0[j]); v1[j] = sigmoid_f(v1[j]); } }
                    u32x4 w; w.x = cvt_pk_bf16(v0[0], v0[1]); w.y = cvt_pk_bf16(v0[2], v0[3]); w.z = cvt_pk_bf16(v1[0], v1[1]); w.w = cvt_pk_bf16(v1[2], v1[3]);
                    *(u32x4*)(rowp + bj * HALF) = w;
                }
            }
    }
};
struct EpiMergeRT {
    static constexpr bool PERM = true, AFTER_DRAIN = false;
    bf16_t* R; const bf16_t* gates;
    __device__ __forceinline__ void operator()(const f32x4 (&acc)[2][2][4][2], const Unit& u, int wr, int wc, int fr, int fq) const {
        const int row0 = u.pm * BM + wr * 64 + fr, col0 = u.pn * BM + wc * 32 + 8 * fq; const int J = u.ks;
#pragma unroll
        for (int ai = 0; ai < 2; ++ai)
#pragma unroll
          for (int mh = 0; mh < 2; ++mh) {
            u32x4 gwv[4][2], rov[4][2];
#pragma unroll
            for (int m = 2 * mh; m < 2 * mh + 2; ++m)
#pragma unroll
                for (int bj = 0; bj < 2; ++bj) {
                    const size_t row = (size_t)(row0 + ai * HALF + m * 16);
                    gwv[m][bj] = *(const u32x4*)(gates + row * 6144 + J * 2048 + col0 + bj * HALF);
                    rov[m][bj] = (u32x4){0u, 0u, 0u, 0u}; if (J > 0) rov[m][bj] = *(const u32x4*)(R + row * 2048 + col0 + bj * HALF);
                }
#pragma unroll
            for (int m = 2 * mh; m < 2 * mh + 2; ++m)
#pragma unroll
                for (int bj = 0; bj < 2; ++bj) {
                    const size_t row = (size_t)(row0 + ai * HALF + m * 16);
                    const u32x4 gw = gwv[m][bj], ro = rov[m][bj];
                    const f32x4 v0 = acc[ai][bj][m][0], v1 = acc[ai][bj][m][1];
                    u32x4 w;
                    w.x = cvt_pk_bf16(bf_lo(ro.x) + bf_lo(gw.x) * v0[0], bf_hi(ro.x) + bf_hi(gw.x) * v0[1]);
                    w.y = cvt_pk_bf16(bf_lo(ro.y) + bf_lo(gw.y) * v0[2], bf_hi(ro.y) + bf_hi(gw.y) * v0[3]);
                    w.z = cvt_pk_bf16(bf_lo(ro.z) + bf_lo(gw.z) * v1[0], bf_hi(ro.z) + bf_hi(gw.z) * v1[1]);
                    w.w = cvt_pk_bf16(bf_lo(ro.w) + bf_lo(gw.w) * v1[2], bf_hi(ro.w) + bf_hi(gw.w) * v1[3]);
                    *(u32x4*)(R + row * 2048 + col0 + bj * HALF) = w;
                }
        }
    }
};
template <int J> struct EpiMerge {
    static constexpr bool PERM = true, AFTER_DRAIN = false;
    bf16_t* R; const bf16_t* gates;
    __device__ __forceinline__ void operator()(const f32x4 (&acc)[2][2][4][2], const Unit& u, int wr, int wc, int fr, int fq) const {
        const int row0 = u.pm * BM + wr * 64 + fr, col0 = u.pn * BM + wc * 32 + 8 * fq;
#pragma unroll
        for (int ai = 0; ai < 2; ++ai)
#pragma unroll
            for (int m = 0; m < 4; ++m) {
                const size_t row = (size_t)(row0 + ai * HALF + m * 16);
#pragma unroll
                for (int bj = 0; bj < 2; ++bj) {
                    const u32x4 gw = *(const u32x4*)(gates + row * 6144 + J * 2048 + col0 + bj * HALF);
                    bf16_t* rp = R + row * 2048 + col0 + bj * HALF;
                    u32x4 ro = (u32x4){0u, 0u, 0u, 0u}; if (J > 0) ro = *(const u32x4*)rp;
                    const f32x4 v0 = acc[ai][bj][m][0], v1 = acc[ai][bj][m][1];
                    u32x4 w;
                    w.x = cvt_pk_bf16(bf_lo(ro.x) + bf_lo(gw.x) * v0[0], bf_hi(ro.x) + bf_hi(gw.x) * v0[1]);
                    w.y = cvt_pk_bf16(bf_lo(ro.y) + bf_lo(gw.y) * v0[2], bf_hi(ro.y) + bf_hi(gw.y) * v0[3]);
                    w.z = cvt_pk_bf16(bf_lo(ro.z) + bf_lo(gw.z) * v1[0], bf_hi(ro.z) + bf_hi(gw.z) * v1[1]);
                    w.w = cvt_pk_bf16(bf_lo(ro.w) + bf_lo(gw.w) * v1[2], bf_hi(ro.w) + bf_hi(gw.w) * v1[3]);
                    *(u32x4*)rp = w;
                }
            }
    }
};
template <class Epi, class Sched, bool ALIGN_EPI = false, bool SP2 = false>
__device__ __forceinline__ void gemm_phase(PG8_LAS unsigned char* lds, const Gemm g, const Sched& S, const Epi& E) {
    const int tid = threadIdx.x, wid = __builtin_amdgcn_readfirstlane(tid >> 6), lane = tid & 63, wr = wid >> 2, wc = wid & 3, fr = lane & 15, fq = lane >> 4;
    const int K = g.K, nt = K / BK;
    unsigned voffA[2], voffB[2];
#pragma unroll
    for (int i = 0; i < 2; ++i) { int R, C; stage_rc(tid * 16 + i * 8192, R, C); const int Rb = Epi::PERM ? ((R & ~31) + perm32(R & 31)) : R;
        voffA[i] = (unsigned)(R * g.lda + C) * 2u; voffB[i] = (unsigned)(Rb * g.ldb + C) * 2u; }
    const size_t kstep = (size_t)(BK * 2);
    const size_t hstepA = (size_t)HALF * g.lda * 2, hstepB = (size_t)HALF * g.ldb * 2;
    const size_t tstepA = 2 * hstepA, tstepB = 2 * hstepB;
    const unsigned ldsw = (unsigned)wid * 1024u;
    const int aoff = lds_byte(wr * 64 + fr, fq * 8), boff = lds_byte(wc * 32 + fr, fq * 8);
#define PG8_SA(b, h) (((b) * 2 + (h)) * HTB)
#define PG8_SB(b, h) ((4 + (b) * 2 + (h)) * HTB)
#define PG8_STAGE(bufoff, gbase, voff) do { _Pragma("unroll") for (int _i = 0; _i < 2; ++_i) \
        __builtin_amdgcn_global_load_lds((const unsigned*)((const char*)(gbase) + (voff)[_i]), (PG8_LAS unsigned*)(lds + (bufoff) + ldsw + _i * 8192), 16, 0, 0); } while (0)
#define PG8_LDA(dst, b, h) do { _Pragma("unroll") for (int m = 0; m < 4; ++m) _Pragma("unroll") for (int k = 0; k < 2; ++k) dst[m][k] = *(const PG8_LAS bf16x8*)(lds + PG8_SA(b, h) + aoff + m * 2048 + k * 1024); } while (0)
#define PG8_LDB(dst, b, h) do { _Pragma("unroll") for (int n = 0; n < 2; ++n) _Pragma("unroll") for (int k = 0; k < 2; ++k) dst[n][k] = *(const PG8_LAS bf16x8*)(lds + PG8_SB(b, h) + boff + n * 2048 + k * 1024); } while (0)
#define PG8_MMA(ai, bj, At, Bt) do { __builtin_amdgcn_s_setprio(1); _Pragma("unroll") for (int m = 0; m < 4; ++m) _Pragma("unroll") for (int n = 0; n < 2; ++n) _Pragma("unroll") for (int k = 0; k < 2; ++k) \
        acc[ai][bj][m][n] = __builtin_amdgcn_mfma_f32_16x16x32_bf16(Bt[n][k], At[m][k], acc[ai][bj][m][n], 0, 0, 0); __builtin_amdgcn_s_setprio(0); } while (0)
#define PG8_WAIT_V(n) asm volatile("s_waitcnt vmcnt(" #n ")" ::: "memory")
#define PG8_WAIT_L(n) asm volatile("s_waitcnt lgkmcnt(" #n ")" ::: "memory")
#define PG8_BAR __builtin_amdgcn_s_barrier()
#define PG8_SCHED __builtin_amdgcn_sched_barrier(0)
    Unit cur, nxt; int ui = 0;
    if (!S.next(0, cur)) return;
    f32x4 acc[2][2][4][2];
#pragma unroll
    for (int a = 0; a < 2; ++a)
#pragma unroll
        for (int b = 0; b < 2; ++b)
#pragma unroll
            for (int m = 0; m < 4; ++m)
#pragma unroll
                for (int n = 0; n < 2; ++n) acc[a][b][m][n] = (f32x4){0.f, 0.f, 0.f, 0.f};
    bf16x8 At[4][2], B0[2][2], B1[2][2];
    const char* cA = (const char*)g.A + (size_t)cur.pm * tstepA + (Sched::KSL != 0 && cur.ks ? (cur.ks - 1) * (Sched::KSL * 2) : 0) + S.a_off(cur); const char* cB = (const char*)g.Bt + (size_t)cur.pn * tstepB + (Sched::KSL != 0 && cur.ks ? (cur.ks - 1) * (Sched::KSL * 2) : 0) + S.b_off(cur);
    S.a_ready(cur);
    if constexpr (SP2) {
        PG8_STAGE(PG8_SB(0, 0), cB, voffB); PG8_STAGE(PG8_SB(0, 1), cB + hstepB, voffB); PG8_STAGE(PG8_SA(0, 0), cA, voffA); PG8_STAGE(PG8_SA(0, 1), cA + hstepA, voffA);
        if (wr == 1) PG8_BAR;
        PG8_WAIT_V(2); PG8_BAR;
        PG8_STAGE(PG8_SB(1, 0), cB + kstep, voffB); PG8_STAGE(PG8_SA(1, 0), cA + kstep, voffA); PG8_STAGE(PG8_SB(1, 1), cB + hstepB + kstep, voffB);
        PG8_WAIT_V(6); PG8_BAR;
    } else {
        PG8_STAGE(PG8_SB(0, 0), cB, voffB); PG8_STAGE(PG8_SA(0, 0), cA, voffA); PG8_STAGE(PG8_SB(0, 1), cB + hstepB, voffB); PG8_STAGE(PG8_SA(0, 1), cA + hstepA, voffA);
        if (wr == 1) PG8_BAR;
        PG8_WAIT_V(4); PG8_BAR;
        PG8_STAGE(PG8_SB(1, 0), cB + kstep, voffB); PG8_STAGE(PG8_SA(1, 0), cA + kstep, voffA); PG8_STAGE(PG8_SB(1, 1), cB + hstepB + kstep, voffB);
        PG8_WAIT_V(6); PG8_BAR;
    }
    for (;;) {
        const bool has_next = S.next(ui + 1, nxt);
        const char* nA = has_next ? (const char*)g.A + (size_t)nxt.pm * tstepA + (Sched::KSL != 0 && nxt.ks ? (nxt.ks - 1) * (Sched::KSL * 2) : 0) + S.a_off(nxt) : cA; const char* nB = has_next ? (const char*)g.Bt + (size_t)nxt.pn * tstepB + (Sched::KSL != 0 && nxt.ks ? (nxt.ks - 1) * (Sched::KSL * 2) : 0) + S.b_off(nxt) : cB;
        const int cnt = (Sched::KSL != 0 && cur.ks) ? Sched::KSL / BK : nt;
        for (int t = 0; t < cnt; t += 2) {
            const bool last = (t == cnt - 2);
            const char* a1 = cA + (size_t)(t + 1) * kstep;
            const char* a2 = last ? nA : cA + (size_t)(t + 2) * kstep; const char* b2 = last ? nB : cB + (size_t)(t + 2) * kstep;
            const char* a3 = a2 + kstep; const char* b3 = b2 + kstep;
            if (last && has_next) S.a_ready(nxt);
            if constexpr (SP2) {
            PG8_LDB(B0, 0, 0); PG8_LDB(B1, 0, 1); PG8_SCHED; PG8_LDA(At, 0, 0); PG8_STAGE(PG8_SA(1, 1), a1 + hstepA, voffA);
            PG8_WAIT_V(8); PG8_WAIT_L(0); PG8_BAR; PG8_MMA(0, 0, At, B0); PG8_MMA(0, 1, At, B1); PG8_BAR; PG8_SCHED;
            PG8_LDA(At, 0, 1); PG8_STAGE(PG8_SB(0, 0), b2, voffB); PG8_STAGE(PG8_SB(0, 1), b2 + hstepB, voffB); PG8_STAGE(PG8_SA(0, 0), a2, voffA);
            PG8_WAIT_V(8); PG8_WAIT_L(0); PG8_BAR; PG8_MMA(1, 0, At, B0); PG8_MMA(1, 1, At, B1); PG8_BAR; PG8_SCHED;
            PG8_LDB(B0, 1, 0); PG8_LDB(B1, 1, 1); PG8_SCHED; PG8_LDA(At, 1, 0); PG8_STAGE(PG8_SA(0, 1), a2 + hstepA, voffA);
            PG8_WAIT_V(8); PG8_WAIT_L(0); PG8_BAR; PG8_MMA(0, 0, At, B0); PG8_MMA(0, 1, At, B1); PG8_BAR; PG8_SCHED;
            PG8_LDA(At, 1, 1); PG8_STAGE(PG8_SB(1, 0), b3, voffB); PG8_STAGE(PG8_SB(1, 1), b3 + hstepB, voffB); PG8_STAGE(PG8_SA(1, 0), a3, voffA);
            PG8_WAIT_V(8); PG8_WAIT_L(0); PG8_BAR; PG8_MMA(1, 0, At, B0); PG8_MMA(1, 1, At, B1); PG8_BAR; PG8_SCHED;
            } else {
            PG8_LDB(B0, 0, 0); PG8_SCHED; PG8_LDA(At, 0, 0); PG8_STAGE(PG8_SA(1, 1), a1 + hstepA, voffA);
            PG8_WAIT_L(8); PG8_BAR; PG8_WAIT_L(0); PG8_MMA(0, 0, At, B0); PG8_BAR; PG8_SCHED;
            PG8_LDB(B1, 0, 1); PG8_STAGE(PG8_SB(0, 0), b2, voffB);
            PG8_BAR; PG8_WAIT_L(0); PG8_MMA(0, 1, At, B1); PG8_BAR;
            PG8_LDA(At, 0, 1); PG8_STAGE(PG8_SA(0, 0), a2, voffA);
            PG8_BAR; PG8_WAIT_L(0); PG8_MMA(1, 0, At, B0); PG8_BAR; PG8_SCHED;
            PG8_STAGE(PG8_SB(0, 1), b2 + hstepB, voffB);
            PG8_WAIT_V(6); PG8_BAR; PG8_MMA(1, 1, At, B1); PG8_BAR;
            PG8_LDB(B0, 1, 0); PG8_SCHED; PG8_LDA(At, 1, 0); PG8_STAGE(PG8_SA(0, 1), a2 + hstepA, voffA);
            PG8_WAIT_L(8); PG8_BAR; PG8_WAIT_L(0); PG8_MMA(0, 0, At, B0); PG8_BAR; PG8_SCHED;
            PG8_LDB(B1, 1, 1); PG8_STAGE(PG8_SB(1, 0), b3, voffB);
            PG8_BAR; PG8_WAIT_L(0); PG8_MMA(0, 1, At, B1); PG8_BAR;
            PG8_LDA(At, 1, 1); PG8_STAGE(PG8_SA(1, 0), a3, voffA);
            PG8_BAR; PG8_WAIT_L(0); PG8_MMA(1, 0, At, B0); PG8_BAR; PG8_SCHED;
            PG8_STAGE(PG8_SB(1, 1), b3 + hstepB, voffB);
            PG8_WAIT_V(6); PG8_BAR; PG8_MMA(1, 1, At, B1); PG8_BAR;
            }
        }
        if constexpr (ALIGN_EPI) { if (wr == 0) PG8_BAR; }
        if constexpr (!Epi::AFTER_DRAIN) { E(acc, cur, wr, wc, fr, fq); S.done(cur); }
        if (!has_next) break;
#pragma unroll
        for (int a = 0; a < 2; ++a)
#pragma unroll
            for (int b = 0; b < 2; ++b)
#pragma unroll
                for (int m = 0; m < 4; ++m)
#pragma unroll
                    for (int n = 0; n < 2; ++n) acc[a][b][m][n] = (f32x4){0.f, 0.f, 0.f, 0.f};
        cur = nxt; cA = nA; cB = nB; ++ui;
        if constexpr (ALIGN_EPI) { if (wr == 1) PG8_BAR; }
    }
    PG8_WAIT_V(0);
    if constexpr (!ALIGN_EPI) { if (wr == 0) PG8_BAR; }
    PG8_BAR;
    if constexpr (Epi::AFTER_DRAIN) { E.fused(acc, cur, wr, wc, fr, fq, lds, wid, lane); S.done(cur); }
#undef PG8_SA
#undef PG8_SB
#undef PG8_STAGE
#undef PG8_LDA
#undef PG8_LDB
#undef PG8_MMA
#undef PG8_WAIT_V
#undef PG8_WAIT_L
#undef PG8_BAR
#undef PG8_SCHED
}
}

#define GAS __attribute__((address_space(1)))
#define LAS __attribute__((address_space(3)))
typedef unsigned short bf16;
typedef unsigned v4u __attribute__((ext_vector_type(4)));
typedef float f32x4 __attribute__((ext_vector_type(4)));
typedef short bf16x8 __attribute__((ext_vector_type(8)));
typedef GAS unsigned gu32;
typedef GAS unsigned long long gu64;
#define RLX_AGENT __ATOMIC_RELAXED, __HIP_MEMORY_SCOPE_AGENT
#define LDS_WAIT() asm volatile("s_waitcnt lgkmcnt(0)" ::: "memory")
#define VM_WAIT() asm volatile("s_waitcnt vmcnt(0)" ::: "memory")
__device__ __forceinline__ unsigned long long rt() { return __builtin_amdgcn_s_memrealtime(); }
__device__ __forceinline__ unsigned f2bf(float f) { unsigned u = __builtin_bit_cast(unsigned, f); return (u + 0x7fffu + ((u >> 16) & 1u)) >> 16; }
__device__ __forceinline__ unsigned pk2(float lo, float hi) { return f2bf(lo) | (f2bf(hi) << 16); }

#define XB_TMO      128
#define XB_XCNT(j)  (256  + 64 * (j))
#define XB_XSUB(j)  (1280 + 64 * (j))
#define XB_XGEN(j)  (2304 + 64 * (j))
#define XB_TOP      3328
#define XB_TOPGEN   3392
#define XCD_BAR_WORDS 3456
#define XB_SPIN_CAP (1u << 18)

__device__ __forceinline__ unsigned xb_ld(unsigned* p)              { return __hip_atomic_load(p, __ATOMIC_RELAXED, __HIP_MEMORY_SCOPE_AGENT); }
__device__ __forceinline__ unsigned xb_add(unsigned* p, unsigned v) { return __hip_atomic_fetch_add(p, v, __ATOMIC_RELAXED, __HIP_MEMORY_SCOPE_AGENT); }
__device__ __forceinline__ unsigned xb_xcc_id() { return (unsigned)__builtin_amdgcn_s_getreg((3 << 11) | 20) & 0xFu; }
#define XB_SPIN(cond, bar) do { unsigned _sp = 0; while (cond) { __builtin_amdgcn_s_sleep(1); \
    if ((++_sp & 255u) == 0u) { if (xb_ld(&(bar)[XB_TMO])) break; if (_sp > XB_SPIN_CAP) { atomicAdd(&(bar)[XB_TMO], 1u); break; } } } } while (0)

struct XcdBarrier {
    unsigned* bar; unsigned x;
    volatile LAS unsigned* st;
};

__device__ __forceinline__ XcdBarrier xcd_barrier_post(unsigned* bar, volatile LAS unsigned* st) {
    XcdBarrier b; b.bar = bar; b.x = xb_xcc_id(); b.st = st;
    if (threadIdx.x == 0) (void)xb_add(&bar[XB_XCNT(b.x)], 1u);
    return b;
}
__device__ __forceinline__ void xcd_barrier_complete(unsigned* bar, unsigned x, unsigned& nloc, unsigned& nx) {
    const unsigned G = gridDim.x * gridDim.y * gridDim.z;
    unsigned sum, cnt, mine, sp = 0u;
    for (;;) {
        sum = 0u; cnt = 0u; mine = 0u;
#pragma unroll
        for (unsigned j = 0; j < 16; ++j) { const unsigned c = xb_ld(&bar[XB_XCNT(j)]); sum += c; cnt += (c > 0u) ? 1u : 0u; mine = (j == x) ? c : mine; }
        if (sum == G) break;
        __builtin_amdgcn_s_sleep(1);
        if ((++sp & 255u) == 0u) { if (xb_ld(&bar[XB_TMO])) break; if (sp > XB_SPIN_CAP) { atomicAdd(&bar[XB_TMO], 1u); break; } }
    }
    nloc = mine > 0u ? mine : 1u; nx = cnt > 0u ? cnt : 1u;
}

__device__ __forceinline__ void xcd_barrier(const XcdBarrier& b) {
    asm volatile("s_waitcnt vmcnt(0)" ::: "memory");
    __syncthreads();
    if (threadIdx.x == 0) {
        unsigned* bar = b.bar;
        __builtin_amdgcn_s_waitcnt(0);
        unsigned nloc = b.st[0], nx = b.st[1];
        if (nloc == 0u) { xcd_barrier_complete(bar, b.x, nloc, nx); b.st[0] = nloc; b.st[1] = nx; }
        const unsigned old = xb_add(&bar[XB_XSUB(b.x)], 1u);
        const unsigned gen = old / nloc;
        if (old + 1u == (gen + 1u) * nloc) {
            __builtin_amdgcn_fence(__ATOMIC_RELEASE, "agent");
            asm volatile("s_waitcnt vmcnt(0)" ::: "memory");
            const unsigned og = xb_add(&bar[XB_TOP], 1u);
            const unsigned tg = og / nx;
            if (og + 1u == (tg + 1u) * nx) xb_add(&bar[XB_TOPGEN], 1u);
            else XB_SPIN(xb_ld(&bar[XB_TOPGEN]) == tg, bar);
            __builtin_amdgcn_fence(__ATOMIC_ACQUIRE, "agent");
            xb_add(&bar[XB_XGEN(b.x)], 1u);
            asm volatile("s_waitcnt vmcnt(0)" ::: "memory");
        } else {
            XB_SPIN(xb_ld(&bar[XB_XGEN(b.x)]) == gen, bar);
            __builtin_amdgcn_fence(__ATOMIC_ACQUIRE, "agent");
            asm volatile("s_waitcnt vmcnt(0)" ::: "memory");
        }
    }
    __syncthreads();
}

constexpr int NWAVES = 8;
constexpr int DM = 2048, SEQ = 16384, CTXL = 256, DFF = 5632, NB = 2;
constexpr int TL = NB * SEQ;
constexpr int TC = NB * CTXL;
constexpr int T = TL + TC;
constexpr int NMOD = 9 * DM;
constexpr int NIN = 12096, NPROJ = 6144;
constexpr float EPSN = 1e-6f;
constexpr int PC_RX = 0, PC_RG = 1024, PC_DQ = 2048, PC_DK = 3072, PC_DV = 4096, PC_QC = 5120, PC_KVC = 5632, PC_KR = 5888;
enum { I_X = 0, I_C, I_CTX, I_CCTX, I_WMOD, I_BMOD, I_NORMG, I_WG, I_WU, I_WD, I_WIN, I_CONVW, I_CONVB, I_WA, I_BA, I_WX, I_BX, I_LAM,
       I_QCN, I_KVCN, I_WUQ, I_WUKV, I_QN, I_KN, I_DQN, I_DKN, I_DLAM, I_DON, I_BP, I_WOUT, N_INPUTS };

constexpr size_t MiB = 1u << 20;
constexpr size_t WS_CTL = 0, CTL_ZERO_BYTES = 1 * MiB;
constexpr size_t WS_MOD = 1 * MiB;
constexpr size_t WS_XC = 2 * MiB;
constexpr size_t WS_AGG = 6 * MiB;
constexpr size_t WS_LAC = 8 * MiB + 512 * 1024;
constexpr size_t WS_ROPE = 9 * MiB;
constexpr size_t WS_W = 13 * MiB;
constexpr size_t W_GU = 0, W_GU_SZ = (size_t)11264 * 2048 * 2;
constexpr size_t W_D = W_GU + 2 * W_GU_SZ, W_D_SZ = (size_t)2048 * 5632 * 2;
constexpr size_t W_IN = W_D + 2 * W_D_SZ, W_IN_SZ = (size_t)6144 * 2048 * 2;
constexpr size_t W_GT = W_IN + W_IN_SZ;
constexpr size_t W_BP = W_GT + W_IN_SZ, W_BP_SZ = (size_t)2048 * 1024 * 2;
constexpr size_t W_OUT = W_BP + 3 * W_BP_SZ;
constexpr size_t W_UQ = W_OUT + (size_t)2048 * 2048 * 2;
constexpr size_t W_UKV = W_UQ + (size_t)1536 * 512 * 2;
constexpr size_t W_LRU = W_UKV + (size_t)2048 * 256 * 2;
constexpr size_t W_END = W_LRU + (size_t)32 * 128 * 128 * 2;
static_assert(W_END <= 204 * MiB, "weights");
constexpr size_t WS_H = WS_W + 204 * MiB;
constexpr size_t WS_PROJ = WS_H + 130 * MiB;
constexpr size_t WS_QRAW = WS_PROJ + 390 * MiB;
constexpr size_t WS_KVRAW = WS_QRAW + 98 * MiB;
constexpr size_t WS_KN = WS_KVRAW + 130 * MiB;
constexpr size_t WS_O12 = WS_KN + 98 * MiB;
constexpr size_t WS_GATES = WS_QRAW;
constexpr size_t WS_BB = WS_O12 + 130 * MiB;
constexpr size_t WS_WAGG = WS_BB + 65 * MiB;
constexpr size_t WS_END = WS_WAGG + 18 * MiB;
static_assert(WS_GATES + 390 * MiB <= WS_BB, "gates overlay");
constexpr int CW_TMO = 0, CW_CODE = 1, CW_BAR = 4096;

constexpr int RING_OFF = 0, RING_BYTES = 131072;
constexpr int LDSCTL_OFF = RING_BYTES, MISC_OFF = LDSCTL_OFF + 320;
constexpr int LRU_SIDE_OFF = 132096;
constexpr int LRU_CW_OFF = LRU_SIDE_OFF + 16384;
constexpr int LRU_CB_OFF = LRU_CW_OFF + 2560;
constexpr int LDS_BYTES = 163840;
struct Args { const float* in[N_INPUTS]; float* out; unsigned char* ws; int ph_lo, ph_hi; };
struct Frame {
    LAS unsigned char* lds;
    volatile LAS unsigned* MISC;
    gu32* ctl;
    int tid, lane, wave, G;
};
__device__ __forceinline__ float wave_sum(float v) {
#pragma unroll
    for (int o = 1; o < 64; o <<= 1) v += __shfl_xor(v, o);
    return v;
}
__device__ __forceinline__ void transpose_item(const float* W, int ldw, bf16* WT, int ldt, int k0, int n0, int drow0, LAS float* scr, int lane) {
    float v[32];
    { const float* src = W + (size_t)(k0 + (lane >> 5)) * ldw + n0 + (lane & 31);
#pragma unroll
      for (int i = 0; i < 32; ++i) v[i] = src[(size_t)(2 * i) * ldw]; }
#pragma unroll
    for (int i = 0; i < 32; ++i) { const int kk = 2 * i + (lane >> 5); scr[kk * 33 + (lane & 31)] = v[i]; }
    LDS_WAIT(); asm volatile("" ::: "memory");
    const int c = lane & 7;
#pragma unroll
    for (int j = 0; j < 4; ++j) { const int n = (lane >> 3) + 8 * j; const LAS float* s = scr + (8 * c) * 33 + n;
        v4u o; o.x = pk2(s[0 * 33], s[1 * 33]); o.y = pk2(s[2 * 33], s[3 * 33]); o.z = pk2(s[4 * 33], s[5 * 33]); o.w = pk2(s[6 * 33], s[7 * 33]);
        *(GAS v4u*)(WT + (size_t)(drow0 + n) * ldt + k0 + 8 * c) = o; }
    LDS_WAIT(); asm volatile("" ::: "memory");
}
__device__ __forceinline__ int win_map(int n0) {
    if (n0 < 2048) return n0;
    if (n0 < 2560) return PC_QC + (n0 - 2048);
    if (n0 < 2816) return PC_KVC + (n0 - 2560);
    if (n0 < 2880) return PC_KR + (n0 - 2816);
    if (n0 < 3904) return PC_DQ + (n0 - 2880);
    if (n0 < 4928) return PC_DK + (n0 - 3904);
    return PC_DV + (n0 - 4928);
}
__device__ __forceinline__ void conv_phase(Frame& F, const Args& a, int l) {
    LAS float* scr = (LAS float*)(F.lds + RING_OFF + F.wave * 16384);
    unsigned char* wb = a.ws + WS_W;
    const int gw = blockIdx.x * NWAVES + F.wave, NGW = F.G * NWAVES;
    constexpr int I_GU = (DM / 64) * (DFF / 32);
    constexpr int I_DN = (DFF / 64) * (DM / 32);
    constexpr int I_IN = (DM / 64) * (NIN / 32);
    constexpr int I_BPJ = (1024 / 64) * (DM / 32);
    constexpr int I_WO = (DM / 64) * (DM / 32);
    constexpr int I_UQ = (512 / 64) * (1536 / 32);
    constexpr int I_UKV = (256 / 64) * (2048 / 32);
    constexpr int I_LRU = 32 * 8;
    constexpr int NITEMS = 4 * I_GU + 2 * I_DN + I_IN + 3 * I_BPJ + I_WO + I_UQ + I_UKV + I_LRU;
    { const float* lam = a.in[I_LAM] + (size_t)l * 2048; float* LAC = (float*)(a.ws + WS_LAC);
      for (int i = blockIdx.x * (NWAVES * 64) + F.tid; i < 2048; i += F.G * NWAVES * 64) LAC[i] = -8.f * 1.4426950408889634f * log1pf(expf(-lam[i])); }
    for (int it = gw; it < NITEMS; it += NGW) {
        int r = it;
        if (r < 4 * I_GU) { const int mat = r / I_GU, s = mat & 1, isup = mat >> 1; r -= mat * I_GU; const int nblk = DFF / 32, k0 = 64 * (r / nblk), n0 = 32 * (r % nblk);
            const float* W = a.in[isup ? I_WU : I_WG] + (size_t)(l * 2 + s) * DM * DFF;
            transpose_item(W, DFF, (bf16*)(wb + W_GU + s * W_GU_SZ), DM, k0, n0, (n0 >> 7) * 256 + (n0 & 127) + isup * 128, scr, F.lane); continue; }
        r -= 4 * I_GU;
        if (r < 2 * I_DN) { const int s = r / I_DN; r -= s * I_DN; const int nblk = DM / 32, k0 = 64 * (r / nblk), n0 = 32 * (r % nblk);
            transpose_item(a.in[I_WD] + (size_t)(l * 2 + s) * DFF * DM, DM, (bf16*)(wb + W_D + s * W_D_SZ), DFF, k0, n0, n0, scr, F.lane); continue; }
        r -= 2 * I_DN;
        if (r < I_IN) { const int nblk = NIN / 32, k0 = 64 * (r / nblk), n0 = 32 * (r % nblk);
            const bool gt = n0 >= 5952;
            transpose_item(a.in[I_WIN] + (size_t)l * DM * NIN, NIN, (bf16*)(wb + (gt ? W_GT : W_IN)), DM, k0, n0, gt ? n0 - 5952 : win_map(n0), scr, F.lane); continue; }
        r -= I_IN;
        if (r < 3 * I_BPJ) { const int j = r / I_BPJ; r -= j * I_BPJ; const int nblk = DM / 32, k0 = 64 * (r / nblk), n0 = 32 * (r % nblk);
            transpose_item(a.in[I_BP] + (size_t)(l * 3 + j) * 1024 * DM, DM, (bf16*)(wb + W_BP + j * W_BP_SZ), 1024, k0, n0, n0, scr, F.lane); continue; }
        r -= 3 * I_BPJ;
        if (r < I_WO) { const int nblk = DM / 32, k0 = 64 * (r / nblk), n0 = 32 * (r % nblk);
            transpose_item(a.in[I_WOUT] + (size_t)l * DM * DM, DM, (bf16*)(wb + W_OUT), DM, k0, n0, n0, scr, F.lane); continue; }
        r -= I_WO;
        if (r < I_UQ) { const int nblk = 1536 / 32, k0 = 64 * (r / nblk), n0 = 32 * (r % nblk);
            transpose_item(a.in[I_WUQ] + (size_t)l * 512 * 1536, 1536, (bf16*)(wb + W_UQ), 512, k0, n0, n0, scr, F.lane); continue; }
        r -= I_UQ;
        if (r < I_UKV) { const int nblk = 2048 / 32, k0 = 64 * (r / nblk), n0 = 32 * (r % nblk);
            transpose_item(a.in[I_WUKV] + (size_t)l * 256 * 2048, 2048, (bf16*)(wb + W_UKV), 256, k0, n0, n0, scr, F.lane); continue; }
        r -= I_UKV;
        { const int mi = r >> 3, sub = r & 7, k0 = 64 * (sub >> 2), n0 = 32 * (sub & 3);
          const int d = mi >> 4, mat = (mi >> 3) & 1, blk = mi & 7;
          const float* W = a.in[mat ? I_WX : I_WA] + (size_t)((l * 2 + d) * 8 + blk) * 128 * 128;
          transpose_item(W, 128, (bf16*)(wb + W_LRU) + (size_t)mi * 128 * 128, 128, k0, n0, n0, scr, F.lane); }
    }
}
__device__ __forceinline__ void mod_phase(Frame& F, const Args& a) {
    LAS float* S = (LAS float*)(F.lds + RING_OFF);
    LAS f32x4* red = (LAS f32x4*)(F.lds + RING_OFF + 3 * 2048 * 4);
    for (int i = F.tid; i < 3 * DM; i += NWAVES * 64) { const int r = i / DM, k = i % DM; const float v = r < 2 ? a.in[I_C][r * DM + k] : a.in[I_CCTX][k]; S[i] = v * __builtin_amdgcn_rcpf(1.f + __builtin_amdgcn_exp2f(-1.4426950408889634f * v)); }
    __syncthreads();
    float* MOD = (float*)(a.ws + WS_MOD);
    for (int unit = blockIdx.x; unit < 2 * 72; unit += F.G) {
        const int l = unit / 72, nb = unit % 72;
        const float* W = a.in[I_WMOD] + (size_t)l * DM * NMOD + nb * 256 + F.lane * 4;
        f32x4 a0 = {0.f, 0.f, 0.f, 0.f}, a1 = a0, a2 = a0;
        const int kb = F.wave * 256;
#pragma unroll 16
        for (int k = kb; k < kb + 256; ++k) { const f32x4 w = *(const f32x4*)(W + (size_t)k * NMOD); a0 += w * S[k]; a1 += w * S[DM + k]; a2 += w * S[2 * DM + k]; }
        red[(F.wave * 3 + 0) * 64 + F.lane] = a0; red[(F.wave * 3 + 1) * 64 + F.lane] = a1; red[(F.wave * 3 + 2) * 64 + F.lane] = a2;
        __syncthreads();
        for (int idx = F.tid; idx < 3 * 256; idx += NWAVES * 64) { const int r = idx >> 8, col = idx & 255; float s = a.in[I_BMOD][l * NMOD + nb * 256 + col];
#pragma unroll
            for (int w = 0; w < 8; ++w) s += ((LAS float*)red)[((w * 3 + r) * 64 + (col >> 2)) * 4 + (col & 3)];
            MOD[(size_t)(l * 3 + r) * NMOD + nb * 256 + col] = s; }
        __syncthreads();
    }
}
__device__ __forceinline__ void norm_phase(Frame& F, const Args& a, int l, int s, const float* xl, const float* xc, const float* part = nullptr, int ns = 0, float* xc_wb = nullptr) {
    const int gw = blockIdx.x * NWAVES + F.wave, NGW = F.G * NWAVES;
    const float* g = a.in[I_NORMG] + (size_t)(l * 3 + s) * DM;
    const float* MOD = (const float*)(a.ws + WS_MOD);
    bf16* H = (bf16*)(a.ws + WS_H);
    for (int m = gw; m < T; m += NGW) {
        const float* src = m < TL ? xl + (size_t)m * DM : xc + (size_t)(m - TL) * DM;
        const int mrow = m < SEQ ? 0 : (m < TL ? 1 : 2);
        const float* mp = MOD + (size_t)(l * 3 + mrow) * NMOD + (size_t)(3 * s) * DM;
        const GAS f32x4* xr = (const GAS f32x4*)src + F.lane;
        f32x4 v[8]; float ss = 0.f;
#pragma unroll
        for (int j = 0; j < 8; ++j) v[j] = xr[64 * j];
        f32x4 gv[8], sc[8], sh[8];
#pragma unroll
        for (int j = 0; j < 8; ++j) { const int col = F.lane * 4 + 256 * j; gv[j] = *(const f32x4*)(g + col); sc[j] = *(const f32x4*)(mp + col); sh[j] = *(const f32x4*)(mp + DM + col); }
        if (part && m >= TL) {
            for (int sl = 0; sl < ns; ++sl) { const GAS f32x4* pr = (const GAS f32x4*)(part + (size_t)sl * (512 * 2048) + (size_t)(m - TL) * DM) + F.lane;
                f32x4 tp[8];
#pragma unroll
                for (int j = 0; j < 8; ++j) tp[j] = pr[64 * j];
                __builtin_amdgcn_sched_barrier(0);
#pragma unroll
                for (int j = 0; j < 8; ++j) v[j] += tp[j]; }
            GAS f32x4* wb = (GAS f32x4*)(xc_wb + (size_t)(m - TL) * DM) + F.lane;
#pragma unroll
            for (int j = 0; j < 8; ++j) wb[64 * j] = v[j];
        }
#pragma unroll
        for (int j = 0; j < 8; ++j) ss += (v[j].x * v[j].x + v[j].y * v[j].y) + (v[j].z * v[j].z + v[j].w * v[j].w);
        const float rstd = 1.0f / sqrtf(wave_sum(ss) * (1.f / DM) + EPSN);
        GAS unsigned long long* o8 = (GAS unsigned long long*)(H + (size_t)m * DM) + F.lane;
#pragma unroll
        for (int j = 0; j < 8; ++j) { const int col = F.lane * 4 + 256 * j;
            const f32x4 o = v[j] * rstd * gv[j] * (sc[j] + 1.0f) + sh[j];
            o8[64 * j] = (unsigned long long)pk2(o.x, o.y) | ((unsigned long long)pk2(o.z, o.w) << 32); }
    }
}
using pg8::sigmoid_f; using pg8::silu_f; using pg8::gelu_tanh_f;
typedef float f32x16 __attribute__((ext_vector_type(16)));
typedef float f32x2v __attribute__((ext_vector_type(2)));

__device__ __forceinline__ int crow16(int r, int hi) { return (r & 3) + 8 * (r >> 2) + 4 * hi; }
__device__ __forceinline__ float bfbits2f(unsigned short b) { return __uint_as_float((unsigned)b << 16); }
template <bool PASS2> __device__ __forceinline__ void lru_phase(Frame& F, const Args& a, int l) {
    bf16* PROJ = (bf16*)(a.ws + WS_PROJ);
    float* AGG = (float*)(a.ws + WS_AGG);
    float* WAGG_G = (float*)(a.ws + WS_WAGG);
    const bf16* WL = (const bf16*)(a.ws + WS_W + W_LRU);
    const float* convw = a.in[I_CONVW] + (size_t)l * 4 * 1024;
    const float* convb = a.in[I_CONVB] + (size_t)l * 1024;
    const float* ba = a.in[I_BA] + (size_t)l * 2 * 1024;
    const float* bx = a.in[I_BX] + (size_t)l * 2 * 1024;
    const float* lam = a.in[I_LAM] + (size_t)l * 2 * 1024;
    LAS f32x2v* WAGG = (LAS f32x2v*)(F.lds + LRU_SIDE_OFF);
    LAS float* HW = (LAS float*)(F.lds + LRU_SIDE_OFF);
    const float* LAC = (const float*)(a.ws + WS_LAC);
    int nb_loaded = -1;
    const int lane = F.lane, tok = lane & 31, hi = lane >> 5, wave = F.wave;
    const int nunits = (PASS2 && l == 1) ? 128 * 8 : 130 * 8;
    for (int unit = blockIdx.x; unit < nunits; unit += F.G) {
        const int pm = unit >> 3, nb = unit & 7;
        const bool isl = pm < 128;
        const int b = isl ? (pm >> 6) : (pm - 128);
        const int jj = isl ? (pm & 63) : 0;
        const int len = isl ? SEQ : CTXL;
        const int pos = (isl ? jj * 256 : 0) + wave * 32 + tok;
        const size_t m = (size_t)pm * 256 + wave * 32 + tok;
        if (nb != nb_loaded) {
            __syncthreads();
            for (int q = F.tid; q < 4 * 2048; q += NWAVES * 64) { const int mi = q >> 11, n = (q >> 4) & 127, c = q & 15;
                const v4u v = *(const v4u*)(WL + ((size_t)(mi * 8 + nb) * 128 + n) * 128 + c * 8);
                *(LAS v4u*)(F.lds + RING_OFF + mi * 32768 + n * 256 + ((c ^ (n & 15)) << 4)) = v; }
            for (int q = F.tid; q < 640; q += NWAVES * 64) { const int r = q >> 7, ch = q & 127;
                ((LAS float*)(F.lds + LRU_CW_OFF))[q] = r < 4 ? convw[r * 1024 + nb * 128 + ch] : convb[nb * 128 + ch]; }
            for (int q = F.tid; q < 768; q += NWAVES * 64) { const int d_ = q / 384, wh = (q % 384) >> 7, ch = q & 127;
                const float* sp = wh == 0 ? ba : (wh == 1 ? bx : LAC);
                ((LAS float*)(F.lds + LRU_CB_OFF))[q] = sp[d_ * 1024 + nb * 128 + ch]; }
            nb_loaded = nb; __syncthreads();
        }
        float tm[4];
#pragma unroll
        for (int j = 0; j < 4; ++j) { const int p = pos + j - 2; tm[j] = (p >= 0 && p < len) ? 1.f : 0.f; }
        const bf16* rp[4];
#pragma unroll
        for (int j = 0; j < 4; ++j) { const long mm = (long)m + (tm[j] != 0.f ? (j - 2) : 0); rp[j] = PROJ + (size_t)mm * NPROJ + PC_RX + nb * 128 + 8 * hi; }
#define LRU_LD(R, G) do { _Pragma("unroll") for (int j_ = 0; j_ < 4; ++j_) { R[0][j_] = *(const v4u*)(rp[j_] + 16 * (2 * (G))); R[1][j_] = *(const v4u*)(rp[j_] + 16 * (2 * (G) + 1)); } } while (0)
        v4u rawA[2][4], rawB[2][4];
        LRU_LD(rawA, 0); LRU_LD(rawB, 1);
        __builtin_amdgcn_sched_barrier(0);
        if (PASS2) {
            if (F.tid < 256) {
                const int d = F.tid >> 7, ch = F.tid & 127, cg = nb * 128 + ch;
                const float* ag = AGG + ((size_t)(b * 2 + d) * 65) * 2048 + (size_t)cg * 2;
                const float* wg = WAGG_G + ((size_t)(pm * 8) * 2 + d) * 2048 + (size_t)cg * 2;
                f32x2v wv[8];
#pragma unroll
                for (int w = 0; w < 8; ++w) wv[w] = *(const f32x2v*)(wg + (size_t)w * 4096);
                float h = 0.f;
                if (isl) {
                    { const f32x2v v = *(const f32x2v*)(ag); h = v.y; }
                    if (d == 0) { for (int j = 0; j < jj; j += 8) { f32x2v v[8];
#pragma unroll
                            for (int k = 0; k < 8; ++k) { const int q = j + k < 63 ? j + k : 63; v[k] = *(const f32x2v*)(ag + (size_t)(1 + q) * 2048); }
#pragma unroll
                            for (int k = 0; k < 8; ++k) if (j + k < jj) h = v[k].x * h + v[k].y; } }
                    else { for (int j = 63; j > jj; j -= 8) { f32x2v v[8];
#pragma unroll
                            for (int k = 0; k < 8; ++k) { const int q = j - k > 0 ? j - k : 0; v[k] = *(const f32x2v*)(ag + (size_t)(1 + q) * 2048); }
#pragma unroll
                            for (int k = 0; k < 8; ++k) if (j - k > jj) h = v[k].x * h + v[k].y; } }
                }
                if (d == 0) { for (int w = 0; w < 8; ++w) { HW[(d * 8 + w) * 128 + ch] = h; h = wv[w].x * h + wv[w].y; } }
                else { for (int w = 7; w >= 0; --w) { HW[(d * 8 + w) * 128 + ch] = h; h = wv[w].x * h + wv[w].y; } }
            }
            __syncthreads();
        }
        bf16x8 xf[8];
        const LAS float* CW = (const LAS float*)(F.lds + LRU_CW_OFF);
#define LRU_CV(R, G) do { _Pragma("unroll") for (int k2_ = 0; k2_ < 2; ++k2_) { const int ks_ = 2 * (G) + k2_, cl = 16 * ks_ + 8 * hi; float xv[8]; \
            { const f32x4 b0 = *(const LAS f32x4*)(CW + 512 + cl), b1 = *(const LAS f32x4*)(CW + 512 + cl + 4); \
              xv[0] = b0.x; xv[1] = b0.y; xv[2] = b0.z; xv[3] = b0.w; xv[4] = b1.x; xv[5] = b1.y; xv[6] = b1.z; xv[7] = b1.w; } \
            _Pragma("unroll") for (int j = 0; j < 4; ++j) { const v4u raw_ = R[k2_][j]; \
                const f32x4 w0 = *(const LAS f32x4*)(CW + j * 128 + cl) * tm[j], w1 = *(const LAS f32x4*)(CW + j * 128 + cl + 4) * tm[j]; \
                xv[0] += w0.x * __uint_as_float(raw_.x << 16); xv[1] += w0.y * __uint_as_float(raw_.x & 0xffff0000u); \
                xv[2] += w0.z * __uint_as_float(raw_.y << 16); xv[3] += w0.w * __uint_as_float(raw_.y & 0xffff0000u); \
                xv[4] += w1.x * __uint_as_float(raw_.z << 16); xv[5] += w1.y * __uint_as_float(raw_.z & 0xffff0000u); \
                xv[6] += w1.z * __uint_as_float(raw_.w << 16); xv[7] += w1.w * __uint_as_float(raw_.w & 0xffff0000u); } \
            v4u p; p.x = pk2(xv[0], xv[1]); p.y = pk2(xv[2], xv[3]); p.z = pk2(xv[4], xv[5]); p.w = pk2(xv[6], xv[7]); \
            xf[ks_] = __builtin_bit_cast(bf16x8, p); } } while (0)
        {
            v4u rawC[2][4];
            LRU_LD(rawC, 2); __builtin_amdgcn_sched_barrier(0);
            LRU_CV(rawA, 0); __builtin_amdgcn_sched_barrier(0);
            LRU_LD(rawA, 3); __builtin_amdgcn_sched_barrier(0);
            LRU_CV(rawB, 1); __builtin_amdgcn_sched_barrier(0);
            LRU_CV(rawC, 2); __builtin_amdgcn_sched_barrier(0);
            LRU_CV(rawA, 3);
        }
#undef LRU_LD
#undef LRU_CV
        __builtin_amdgcn_sched_barrier(0);
#pragma unroll 1
        for (int mb = 0; mb < 4; ++mb) {
            const int cb = nb * 128 + 32 * mb;
            unsigned long long rgv[4];
            if (PASS2) {
#pragma unroll
                for (int g = 0; g < 4; ++g) rgv[g] = *(const unsigned long long*)(PROJ + m * NPROJ + PC_RG + cb + 8 * g + 4 * hi);
            }
            float xa[16];
            {
                const v4u e0 = __builtin_bit_cast(v4u, xf[0]), e1 = __builtin_bit_cast(v4u, xf[1]), e2 = __builtin_bit_cast(v4u, xf[2]), e3 = __builtin_bit_cast(v4u, xf[3]);
                const v4u e4 = __builtin_bit_cast(v4u, xf[4]), e5 = __builtin_bit_cast(v4u, xf[5]), e6 = __builtin_bit_cast(v4u, xf[6]), e7 = __builtin_bit_cast(v4u, xf[7]);
                const v4u va = mb == 0 ? e0 : (mb == 1 ? e2 : (mb == 2 ? e4 : e6)), vb = mb == 0 ? e1 : (mb == 1 ? e3 : (mb == 2 ? e5 : e7));
                const auto ra0 = __builtin_amdgcn_permlane32_swap(va.x, va.z, false, false); const auto ra1 = __builtin_amdgcn_permlane32_swap(va.y, va.w, false, false);
                const auto rb0 = __builtin_amdgcn_permlane32_swap(vb.x, vb.z, false, false); const auto rb1 = __builtin_amdgcn_permlane32_swap(vb.y, vb.w, false, false);
                unsigned lo32[4], hi32[4];
                lo32[0] = hi ? ra0[0] : va.x; hi32[0] = hi ? ra1[0] : va.y;
                lo32[1] = hi ? va.z : ra0[1]; hi32[1] = hi ? va.w : ra1[1];
                lo32[2] = hi ? rb0[0] : vb.x; hi32[2] = hi ? rb1[0] : vb.y;
                lo32[3] = hi ? vb.z : rb0[1]; hi32[3] = hi ? vb.w : rb1[1];
#pragma unroll
                for (int g = 0; g < 4; ++g) { xa[4 * g + 0] = __uint_as_float(lo32[g] << 16); xa[4 * g + 1] = __uint_as_float(lo32[g] & 0xffff0000u);
                    xa[4 * g + 2] = __uint_as_float(hi32[g] << 16); xa[4 * g + 3] = __uint_as_float(hi32[g] & 0xffff0000u); }
            }
            float hsum[16];
#pragma unroll
            for (int e = 0; e < 16; ++e) hsum[e] = 0.f;
#pragma unroll
            for (int d = 0; d < 2; ++d) {
                __builtin_amdgcn_sched_barrier(0);
                f32x16 ar = {}, ai = {};
                const int nrow = 32 * mb + tok;
                const LAS unsigned char* wra = F.lds + RING_OFF + (d * 2 + 0) * 32768 + nrow * 256;
                const LAS unsigned char* wri = F.lds + RING_OFF + (d * 2 + 1) * 32768 + nrow * 256;
#pragma unroll
                for (int ks = 0; ks < 8; ++ks) {
                    const int cofs = ((2 * ks + hi) ^ (nrow & 15)) << 4;
                    const bf16x8 fa = *(const LAS bf16x8*)(wra + cofs), fi = *(const LAS bf16x8*)(wri + cofs);
                    ar = __builtin_amdgcn_mfma_f32_32x32x16_bf16(fa, xf[ks], ar, 0, 0, 0);
                    ai = __builtin_amdgcn_mfma_f32_32x32x16_bf16(fi, xf[ks], ai, 0, 0, 0);
                }
                __builtin_amdgcn_sched_barrier(0);
                float ca[16], cu[16];
#pragma unroll
                for (int g = 0; g < 4; ++g) { const int c0 = cb + 8 * g + 4 * hi;
                    const LAS float* cbp = (const LAS float*)(F.lds + LRU_CB_OFF) + d * 384 + 32 * mb + 8 * g + 4 * hi;
                    const f32x4 vba = *(const LAS f32x4*)(cbp), vbx = *(const LAS f32x4*)(cbp + 128), vl = *(const LAS f32x4*)(cbp + 256);
#pragma unroll
                    for (int i = 0; i < 4; ++i) { const int e = 4 * g + i;
                        const float r = sigmoid_f(ar[e] + vba[i]), ig = sigmoid_f(ai[e] + vbx[i]);
                        const float la2 = r * vl[i];
                        const float av = __builtin_amdgcn_exp2f(la2);
                        ca[e] = av; cu[e] = __builtin_amdgcn_sqrtf(fmaxf(1.f - av * av, 0.f)) * (ig * xa[e]); }
                }
                __builtin_amdgcn_sched_barrier(0);
#define LRU_DPP_BLOCK(E0, BODY) asm(BODY \
                    : "+v"(cu[E0 + 0]), "+v"(cu[E0 + 1]), "+v"(cu[E0 + 2]), "+v"(cu[E0 + 3]), "+v"(cu[E0 + 4]), "+v"(cu[E0 + 5]), "+v"(cu[E0 + 6]), "+v"(cu[E0 + 7]), \
                      "+v"(ca[E0 + 0]), "+v"(ca[E0 + 1]), "+v"(ca[E0 + 2]), "+v"(ca[E0 + 3]), "+v"(ca[E0 + 4]), "+v"(ca[E0 + 5]), "+v"(ca[E0 + 6]), "+v"(ca[E0 + 7]))
#define LRU_SCAN_SHR \
                    "s_nop 4\n\t" \
                    "v_fmac_f32_dpp %0, %0, %8 row_shr:1 row_mask:0xf bank_mask:0xf\n\t" \
                    "v_mul_f32_dpp %8, %8, %8 row_shr:1 row_mask:0xf bank_mask:0xf\n\t" \
                    "v_fmac_f32_dpp %1, %1, %9 row_shr:1 row_mask:0xf bank_mask:0xf\n\t" \
                    "v_mul_f32_dpp %9, %9, %9 row_shr:1 row_mask:0xf bank_mask:0xf\n\t" \
                    "v_fmac_f32_dpp %2, %2, %10 row_shr:1 row_mask:0xf bank_mask:0xf\n\t" \
                    "v_mul_f32_dpp %10, %10, %10 row_shr:1 row_mask:0xf bank_mask:0xf\n\t" \
                    "v_fmac_f32_dpp %3, %3, %11 row_shr:1 row_mask:0xf bank_mask:0xf\n\t" \
                    "v_mul_f32_dpp %11, %11, %11 row_shr:1 row_mask:0xf bank_mask:0xf\n\t" \
                    "v_fmac_f32_dpp %4, %4, %12 row_shr:1 row_mask:0xf bank_mask:0xf\n\t" \
                    "v_mul_f32_dpp %12, %12, %12 row_shr:1 row_mask:0xf bank_mask:0xf\n\t" \
                    "v_fmac_f32_dpp %5, %5, %13 row_shr:1 row_mask:0xf bank_mask:0xf\n\t" \
                    "v_mul_f32_dpp %13, %13, %13 row_shr:1 row_mask:0xf bank_mask:0xf\n\t" \
                    "v_fmac_f32_dpp %6, %6, %14 row_shr:1 row_mask:0xf bank_mask:0xf\n\t" \
                    "v_mul_f32_dpp %14, %14, %14 row_shr:1 row_mask:0xf bank_mask:0xf\n\t" \
                    "v_fmac_f32_dpp %7, %7, %15 row_shr:1 row_mask:0xf bank_mask:0xf\n\t" \
                    "v_mul_f32_dpp %15, %15, %15 row_shr:1 row_mask:0xf bank_mask:0xf\n\t" \
                    "v_fmac_f32_dpp %0, %0, %8 row_shr:2 row_mask:0xf bank_mask:0xf\n\t" \
                    "v_mul_f32_dpp %8, %8, %8 row_shr:2 row_mask:0xf bank_mask:0xf\n\t" \
                    "v_fmac_f32_dpp %1, %1, %9 row_shr:2 row_mask:0xf bank_mask:0xf\n\t" \
                    "v_mul_f32_dpp %9, %9, %9 row_shr:2 row_mask:0xf bank_mask:0xf\n\t" \
                    "v_fmac_f32_dpp %2, %2, %10 row_shr:2 row_mask:0xf bank_mask:0xf\n\t" \
                    "v_mul_f32_dpp %10, %10, %10 row_shr:2 row_mask:0xf bank_mask:0xf\n\t" \
                    "v_fmac_f32_dpp %3, %3, %11 row_shr:2 row_mask:0xf bank_mask:0xf\n\t" \
                    "v_mul_f32_dpp %11, %11, %11 row_shr:2 row_mask:0xf bank_mask:0xf\n\t" \
                    "v_fmac_f32_dpp %4, %4, %12 row_shr:2 row_mask:0xf bank_mask:0xf\n\t" \
                    "v_mul_f32_dpp %12, %12, %12 row_shr:2 row_mask:0xf bank_mask:0xf\n\t" \
                    "v_fmac_f32_dpp %5, %5, %13 row_shr:2 row_mask:0xf bank_mask:0xf\n\t" \
                    "v_mul_f32_dpp %13, %13, %13 row_shr:2 row_mask:0xf bank_mask:0xf\n\t" \
                    "v_fmac_f32_dpp %6, %6, %14 row_shr:2 row_mask:0xf bank_mask:0xf\n\t" \
                    "v_mul_f32_dpp %14, %14, %14 row_shr:2 row_mask:0xf bank_mask:0xf\n\t" \
                    "v_fmac_f32_dpp %7, %7, %15 row_shr:2 row_mask:0xf bank_mask:0xf\n\t" \
                    "v_mul_f32_dpp %15, %15, %15 row_shr:2 row_mask:0xf bank_mask:0xf\n\t" \
                    "v_fmac_f32_dpp %0, %0, %8 row_shr:4 row_mask:0xf bank_mask:0xf\n\t" \
                    "v_mul_f32_dpp %8, %8, %8 row_shr:4 row_mask:0xf bank_mask:0xf\n\t" \
                    "v_fmac_f32_dpp %1, %1, %9 row_shr:4 row_mask:0xf bank_mask:0xf\n\t" \
                    "v_mul_f32_dpp %9, %9, %9 row_shr:4 row_mask:0xf bank_mask:0xf\n\t" \
                    "v_fmac_f32_dpp %2, %2, %10 row_shr:4 row_mask:0xf bank_mask:0xf\n\t" \
                    "v_mul_f32_dpp %10, %10, %10 row_shr:4 row_mask:0xf bank_mask:0xf\n\t" \
                    "v_fmac_f32_dpp %3, %3, %11 row_shr:4 row_mask:0xf bank_mask:0xf\n\t" \
                    "v_mul_f32_dpp %11, %11, %11 row_shr:4 row_mask:0xf bank_mask:0xf\n\t" \
                    "v_fmac_f32_dpp %4, %4, %12 row_shr:4 row_mask:0xf bank_mask:0xf\n\t" \
                    "v_mul_f32_dpp %12, %12, %12 row_shr:4 row_mask:0xf bank_mask:0xf\n\t" \
                    "v_fmac_f32_dpp %5, %5, %13 row_shr:4 row_mask:0xf bank_mask:0xf\n\t" \
                    "v_mul_f32_dpp %13, %13, %13 row_shr:4 row_mask:0xf bank_mask:0xf\n\t" \
                    "v_fmac_f32_dpp %6, %6, %14 row_shr:4 row_mask:0xf bank_mask:0xf\n\t" \
                    "v_mul_f32_dpp %14, %14, %14 row_shr:4 row_mask:0xf bank_mask:0xf\n\t" \
                    "v_fmac_f32_dpp %7, %7, %15 row_shr:4 row_mask:0xf bank_mask:0xf\n\t" \
                    "v_mul_f32_dpp %15, %15, %15 row_shr:4 row_mask:0xf bank_mask:0xf\n\t" \
                    "v_fmac_f32_dpp %0, %0, %8 row_shr:8 row_mask:0xf bank_mask:0xf\n\t" \
                    "v_mul_f32_dpp %8, %8, %8 row_shr:8 row_mask:0xf bank_mask:0xf\n\t" \
                    "v_fmac_f32_dpp %1, %1, %9 row_shr:8 row_mask:0xf bank_mask:0xf\n\t" \
                    "v_mul_f32_dpp %9, %9, %9 row_shr:8 row_mask:0xf bank_mask:0xf\n\t" \
                    "v_fmac_f32_dpp %2, %2, %10 row_shr:8 row_mask:0xf bank_mask:0xf\n\t" \
                    "v_mul_f32_dpp %10, %10, %10 row_shr:8 row_mask:0xf bank_mask:0xf\n\t" \
                    "v_fmac_f32_dpp %3, %3, %11 row_shr:8 row_mask:0xf bank_mask:0xf\n\t" \
                    "v_mul_f32_dpp %11, %11, %11 row_shr:8 row_mask:0xf bank_mask:0xf\n\t" \
                    "v_fmac_f32_dpp %4, %4, %12 row_shr:8 row_mask:0xf bank_mask:0xf\n\t" \
                    "v_mul_f32_dpp %12, %12, %12 row_shr:8 row_mask:0xf bank_mask:0xf\n\t" \
                    "v_fmac_f32_dpp %5, %5, %13 row_shr:8 row_mask:0xf bank_mask:0xf\n\t" \
                    "v_mul_f32_dpp %13, %13, %13 row_shr:8 row_mask:0xf bank_mask:0xf\n\t" \
                    "v_fmac_f32_dpp %6, %6, %14 row_shr:8 row_mask:0xf bank_mask:0xf\n\t" \
                    "v_mul_f32_dpp %14, %14, %14 row_shr:8 row_mask:0xf bank_mask:0xf\n\t" \
                    "v_fmac_f32_dpp %7, %7, %15 row_shr:8 row_mask:0xf bank_mask:0xf\n\t" \
                    "v_mul_f32_dpp %15, %15, %15 row_shr:8 row_mask:0xf bank_mask:0xf\n\t" \
                    "s_nop 1"
#define LRU_SCAN_SHL \
                    "s_nop 4\n\t" \
                    "v_fmac_f32_dpp %0, %0, %8 row_shl:1 row_mask:0xf bank_mask:0xf\n\t" \
                    "v_mul_f32_dpp %8, %8, %8 row_shl:1 row_mask:0xf bank_mask:0xf\n\t" \
                    "v_fmac_f32_dpp %1, %1, %9 row_shl:1 row_mask:0xf bank_mask:0xf\n\t" \
                    "v_mul_f32_dpp %9, %9, %9 row_shl:1 row_mask:0xf bank_mask:0xf\n\t" \
                    "v_fmac_f32_dpp %2, %2, %10 row_shl:1 row_mask:0xf bank_mask:0xf\n\t" \
                    "v_mul_f32_dpp %10, %10, %10 row_shl:1 row_mask:0xf bank_mask:0xf\n\t" \
                    "v_fmac_f32_dpp %3, %3, %11 row_shl:1 row_mask:0xf bank_mask:0xf\n\t" \
                    "v_mul_f32_dpp %11, %11, %11 row_shl:1 row_mask:0xf bank_mask:0xf\n\t" \
                    "v_fmac_f32_dpp %4, %4, %12 row_shl:1 row_mask:0xf bank_mask:0xf\n\t" \
                    "v_mul_f32_dpp %12, %12, %12 row_shl:1 row_mask:0xf bank_mask:0xf\n\t" \
                    "v_fmac_f32_dpp %5, %5, %13 row_shl:1 row_mask:0xf bank_mask:0xf\n\t" \
                    "v_mul_f32_dpp %13, %13, %13 row_shl:1 row_mask:0xf bank_mask:0xf\n\t" \
                    "v_fmac_f32_dpp %6, %6, %14 row_shl:1 row_mask:0xf bank_mask:0xf\n\t" \
                    "v_mul_f32_dpp %14, %14, %14 row_shl:1 row_mask:0xf bank_mask:0xf\n\t" \
                    "v_fmac_f32_dpp %7, %7, %15 row_shl:1 row_mask:0xf bank_mask:0xf\n\t" \
                    "v_mul_f32_dpp %15, %15, %15 row_shl:1 row_mask:0xf bank_mask:0xf\n\t" \
                    "v_fmac_f32_dpp %0, %0, %8 row_shl:2 row_mask:0xf bank_mask:0xf\n\t" \
                    "v_mul_f32_dpp %8, %8, %8 row_shl:2 row_mask:0xf bank_mask:0xf\n\t" \
                    "v_fmac_f32_dpp %1, %1, %9 row_shl:2 row_mask:0xf bank_mask:0xf\n\t" \
                    "v_mul_f32_dpp %9, %9, %9 row_shl:2 row_mask:0xf bank_mask:0xf\n\t" \
                    "v_fmac_f32_dpp %2, %2, %10 row_shl:2 row_mask:0xf bank_mask:0xf\n\t" \
                    "v_mul_f32_dpp %10, %10, %10 row_shl:2 row_mask:0xf bank_mask:0xf\n\t" \
                    "v_fmac_f32_dpp %3, %3, %11 row_shl:2 row_mask:0xf bank_mask:0xf\n\t" \
                    "v_mul_f32_dpp %11, %11, %11 row_shl:2 row_mask:0xf bank_mask:0xf\n\t" \
                    "v_fmac_f32_dpp %4, %4, %12 row_shl:2 row_mask:0xf bank_mask:0xf\n\t" \
                    "v_mul_f32_dpp %12, %12, %12 row_shl:2 row_mask:0xf bank_mask:0xf\n\t" \
                    "v_fmac_f32_dpp %5, %5, %13 row_shl:2 row_mask:0xf bank_mask:0xf\n\t" \
                    "v_mul_f32_dpp %13, %13, %13 row_shl:2 row_mask:0xf bank_mask:0xf\n\t" \
                    "v_fmac_f32_dpp %6, %6, %14 row_shl:2 row_mask:0xf bank_mask:0xf\n\t" \
                    "v_mul_f32_dpp %14, %14, %14 row_shl:2 row_mask:0xf bank_mask:0xf\n\t" \
                    "v_fmac_f32_dpp %7, %7, %15 row_shl:2 row_mask:0xf bank_mask:0xf\n\t" \
                    "v_mul_f32_dpp %15, %15, %15 row_shl:2 row_mask:0xf bank_mask:0xf\n\t" \
                    "v_fmac_f32_dpp %0, %0, %8 row_shl:4 row_mask:0xf bank_mask:0xf\n\t" \
                    "v_mul_f32_dpp %8, %8, %8 row_shl:4 row_mask:0xf bank_mask:0xf\n\t" \
                    "v_fmac_f32_dpp %1, %1, %9 row_shl:4 row_mask:0xf bank_mask:0xf\n\t" \
                    "v_mul_f32_dpp %9, %9, %9 row_shl:4 row_mask:0xf bank_mask:0xf\n\t" \
                    "v_fmac_f32_dpp %2, %2, %10 row_shl:4 row_mask:0xf bank_mask:0xf\n\t" \
                    "v_mul_f32_dpp %10, %10, %10 row_shl:4 row_mask:0xf bank_mask:0xf\n\t" \
                    "v_fmac_f32_dpp %3, %3, %11 row_shl:4 row_mask:0xf bank_mask:0xf\n\t" \
                    "v_mul_f32_dpp %11, %11, %11 row_shl:4 row_mask:0xf bank_mask:0xf\n\t" \
                    "v_fmac_f32_dpp %4, %4, %12 row_shl:4 row_mask:0xf bank_mask:0xf\n\t" \
                    "v_mul_f32_dpp %12, %12, %12 row_shl:4 row_mask:0xf bank_mask:0xf\n\t" \
                    "v_fmac_f32_dpp %5, %5, %13 row_shl:4 row_mask:0xf bank_mask:0xf\n\t" \
                    "v_mul_f32_dpp %13, %13, %13 row_shl:4 row_mask:0xf bank_mask:0xf\n\t" \
                    "v_fmac_f32_dpp %6, %6, %14 row_shl:4 row_mask:0xf bank_mask:0xf\n\t" \
                    "v_mul_f32_dpp %14, %14, %14 row_shl:4 row_mask:0xf bank_mask:0xf\n\t" \
                    "v_fmac_f32_dpp %7, %7, %15 row_shl:4 row_mask:0xf bank_mask:0xf\n\t" \
                    "v_mul_f32_dpp %15, %15, %15 row_shl:4 row_mask:0xf bank_mask:0xf\n\t" \
                    "v_fmac_f32_dpp %0, %0, %8 row_shl:8 row_mask:0xf bank_mask:0xf\n\t" \
                    "v_mul_f32_dpp %8, %8, %8 row_shl:8 row_mask:0xf bank_mask:0xf\n\t" \
                    "v_fmac_f32_dpp %1, %1, %9 row_shl:8 row_mask:0xf bank_mask:0xf\n\t" \
                    "v_mul_f32_dpp %9, %9, %9 row_shl:8 row_mask:0xf bank_mask:0xf\n\t" \
                    "v_fmac_f32_dpp %2, %2, %10 row_shl:8 row_mask:0xf bank_mask:0xf\n\t" \
                    "v_mul_f32_dpp %10, %10, %10 row_shl:8 row_mask:0xf bank_mask:0xf\n\t" \
                    "v_fmac_f32_dpp %3, %3, %11 row_shl:8 row_mask:0xf bank_mask:0xf\n\t" \
                    "v_mul_f32_dpp %11, %11, %11 row_shl:8 row_mask:0xf bank_mask:0xf\n\t" \
                    "v_fmac_f32_dpp %4, %4, %12 row_shl:8 row_mask:0xf bank_mask:0xf\n\t" \
                    "v_mul_f32_dpp %12, %12, %12 row_shl:8 row_mask:0xf bank_mask:0xf\n\t" \
                    "v_fmac_f32_dpp %5, %5, %13 row_shl:8 row_mask:0xf bank_mask:0xf\n\t" \
                    "v_mul_f32_dpp %13, %13, %13 row_shl:8 row_mask:0xf bank_mask:0xf\n\t" \
                    "v_fmac_f32_dpp %6, %6, %14 row_shl:8 row_mask:0xf bank_mask:0xf\n\t" \
                    "v_mul_f32_dpp %14, %14, %14 row_shl:8 row_mask:0xf bank_mask:0xf\n\t" \
                    "v_fmac_f32_dpp %7, %7, %15 row_shl:8 row_mask:0xf bank_mask:0xf\n\t" \
                    "v_mul_f32_dpp %15, %15, %15 row_shl:8 row_mask:0xf bank_mask:0xf\n\t" \
                    "s_nop 1"
                if (d == 0) { LRU_DPP_BLOCK(0, LRU_SCAN_SHR); LRU_DPP_BLOCK(8, LRU_SCAN_SHR); }
                else        { LRU_DPP_BLOCK(0, LRU_SCAN_SHL); LRU_DPP_BLOCK(8, LRU_SCAN_SHL); }
#undef LRU_DPP_BLOCK
#undef LRU_SCAN_SHR
#undef LRU_SCAN_SHL
                {
                    const bool second = d == 0 ? ((lane & 16) != 0) : ((lane & 16) == 0);
#pragma unroll
                    for (int e = 0; e < 16; ++e) {
                        const int ia = __builtin_bit_cast(int, ca[e]), iu = __builtin_bit_cast(int, cu[e]);
                        const int ta0 = __builtin_amdgcn_readlane(ia, d == 0 ? 15 : 16), ta1 = __builtin_amdgcn_readlane(ia, d == 0 ? 47 : 48);
                        const int tu0 = __builtin_amdgcn_readlane(iu, d == 0 ? 15 : 16), tu1 = __builtin_amdgcn_readlane(iu, d == 0 ? 47 : 48);
                        const float ta = __builtin_bit_cast(float, hi ? ta1 : ta0), tu = __builtin_bit_cast(float, hi ? tu1 : tu0);
                        if (second) { cu[e] = ca[e] * tu + cu[e]; ca[e] = ca[e] * ta; }
                        if ((e & 1) == 1) __builtin_amdgcn_sched_barrier(0);
                    }
                }
                __builtin_amdgcn_sched_barrier(0);
                if (!PASS2) {
                    if (tok == (d == 0 ? 31 : 0)) {
                        float* wg = WAGG_G + ((size_t)(pm * 8 + wave) * 2 + d) * 2048;
#pragma unroll
                        for (int e = 0; e < 16; ++e) { const int ch = 32 * mb + crow16(e, hi); const f32x2v v = {ca[e], cu[e]};
                            WAGG[(d * 8 + wave) * 128 + ch] = v; *(f32x2v*)(wg + (size_t)(nb * 128 + ch) * 2) = v; }
                    }
                } else {
#pragma unroll
                    for (int e = 0; e < 16; ++e) { const float hin = HW[(d * 8 + wave) * 128 + 32 * mb + crow16(e, hi)]; hsum[e] += ca[e] * hin + cu[e]; }
                }
            }
            if (PASS2) {
#pragma unroll
                for (int g = 0; g < 4; ++g) { const int c0 = cb + 8 * g + 4 * hi;
                    unsigned long long* p = (unsigned long long*)(PROJ + m * NPROJ + PC_RG + c0);
                    const unsigned long long raw = rgv[g]; const unsigned lo32 = (unsigned)raw, hi32 = (unsigned)(raw >> 32);
                    const float y0 = hsum[4 * g + 0] * __uint_as_float(lo32 << 16), y1 = hsum[4 * g + 1] * __uint_as_float(lo32 & 0xffff0000u);
                    const float y2 = hsum[4 * g + 2] * __uint_as_float(hi32 << 16), y3 = hsum[4 * g + 3] * __uint_as_float(hi32 & 0xffff0000u);
                    *p = (unsigned long long)pk2(y0, y1) | ((unsigned long long)pk2(y2, y3) << 32); }
            }
        }
        if (!PASS2) {
            __syncthreads();
            if (F.tid < 256) {
                const int d = F.tid >> 7, ch = F.tid & 127;
                float A = 1.f, U = 0.f;
                if (d == 0) { for (int w = 0; w < 8; ++w) { const f32x2v v = WAGG[(d * 8 + w) * 128 + ch]; U = v.x * U + v.y; A = A * v.x; } }
                else { for (int w = 7; w >= 0; --w) { const f32x2v v = WAGG[(d * 8 + w) * 128 + ch]; U = v.x * U + v.y; A = A * v.x; } }
                const int ci = isl ? 1 + jj : 0;
                *(f32x2v*)(AGG + ((size_t)(b * 2 + d) * 65 + ci) * 2048 + (size_t)(nb * 128 + ch) * 2) = (f32x2v){A, U};
            }
        }
        __syncthreads();
    }
}
namespace att {
using bf16x8 = __attribute__((ext_vector_type(8))) short;
using s16x4  = __attribute__((ext_vector_type(4))) short;
using f32x16 = __attribute__((ext_vector_type(16))) float;
using u32x4  = __attribute__((ext_vector_type(4))) unsigned;
constexpr int QBLK = 32, KVBLK = 64, NW = 8;
constexpr float THR = 8.f;
#define ATT_SBAR() __builtin_amdgcn_sched_barrier(0)
__device__ __forceinline__ int crow(int r, int hi) { return (r & 3) + 8 * (r >> 2) + 4 * hi; }
__device__ __forceinline__ unsigned cvtpk(float lo, float hi) { return pg8::cvt_pk_bf16(lo, hi); }
__device__ __forceinline__ void partialSM(f32x16& p0, f32x16& p1, float& m_reg, float& mn, float& alpha) {
  float pmax = p0[0];
#pragma unroll
  for (int r = 1; r < 16; ++r) pmax = fmaxf(pmax, p0[r]);
#pragma unroll
  for (int r = 0; r < 16; ++r) pmax = fmaxf(pmax, p1[r]);
  { auto rr = __builtin_amdgcn_permlane32_swap(__float_as_uint(pmax), __float_as_uint(pmax), false, false);
    pmax = fmaxf(__uint_as_float(rr[0]), __uint_as_float(rr[1])); }
  if (__builtin_expect(__all(pmax - m_reg <= THR), 1)) { mn = m_reg; alpha = 1.f; }
  else { mn = fmaxf(m_reg, pmax); alpha = __builtin_amdgcn_exp2f(m_reg - mn); m_reg = mn; }
#pragma unroll
  for (int r = 0; r < 16; ++r) p0[r] = p0[r] - mn;
#pragma unroll
  for (int r = 0; r < 16; ++r) p1[r] = p1[r] - mn;
#pragma unroll
  for (int r = 0; r < 16; ++r) p0[r] = __builtin_amdgcn_exp2f(p0[r]);
}
__device__ __forceinline__ void finishSM(f32x16& p0, f32x16& p1, float alpha, float& l_reg, bf16x8& pa0, bf16x8& pa1, bf16x8& pa2, bf16x8& pa3) {
#pragma unroll
  for (int r = 0; r < 16; ++r) p1[r] = __builtin_amdgcn_exp2f(p1[r]);
  float ps = 0;
#pragma unroll
  for (int r = 0; r < 16; ++r) ps += p0[r];
#pragma unroll
  for (int r = 0; r < 16; ++r) ps += p1[r];
  { auto rr = __builtin_amdgcn_permlane32_swap(__float_as_uint(ps), __float_as_uint(ps), false, false);
    ps = __uint_as_float(rr[0]) + __uint_as_float(rr[1]); }
  l_reg = l_reg * alpha + ps;
#define ATT_PK4(P, BASE, OUT) do { unsigned a0 = cvtpk(P[BASE + 0], P[BASE + 1]), a1 = cvtpk(P[BASE + 2], P[BASE + 3]);   \
    unsigned b0 = cvtpk(P[BASE + 4], P[BASE + 5]), b1 = cvtpk(P[BASE + 6], P[BASE + 7]);                              \
    auto r0 = __builtin_amdgcn_permlane32_swap(a0, b0, false, false); auto r1 = __builtin_amdgcn_permlane32_swap(a1, b1, false, false); \
    u32x4 w = {r0[0], r1[0], r0[1], r1[1]}; OUT = *reinterpret_cast<bf16x8*>(&w); } while (0)
  ATT_PK4(p0, 0, pa0); ATT_PK4(p0, 8, pa1); ATT_PK4(p1, 0, pa2); ATT_PK4(p1, 8, pa3);
#undef ATT_PK4
}
template <int DQK> __device__ __forceinline__ int kswz(int row, int colB) { return row * (DQK * 2) + (colB ^ (((row >> 1) & 7) << 4)); }
template <int DQK> __device__ __forceinline__ void qkt(f32x16& p0, f32x16& p1, const __attribute__((address_space(3))) unsigned char* Ks, const bf16x8* qr, int r32, int hi) {
  p0 = f32x16{}; p1 = f32x16{};
#pragma unroll
  for (int d0 = 0; d0 < DQK / 16; ++d0) { const int cb = (d0 * 16 + hi * 8) * 2;
    const bf16x8 b0 = *(const __attribute__((address_space(3))) bf16x8*)(Ks + kswz<DQK>(r32, cb));
    const bf16x8 b1 = *(const __attribute__((address_space(3))) bf16x8*)(Ks + kswz<DQK>(32 + r32, cb));
    p0 = __builtin_amdgcn_mfma_f32_32x32x16_bf16(b0, qr[d0], p0, 0, 0, 0);
    p1 = __builtin_amdgcn_mfma_f32_32x32x16_bf16(b1, qr[d0], p1, 0, 0, 0); }
}
__device__ __forceinline__ int v_st(int k, int c) { const int kk = (k & ~0xC) | ((k & 4) << 1) | ((k & 8) >> 1); return ((kk >> 3) * 4 + (c >> 5)) * 512 + ((kk & 7) * 32 + (c & 31)) * 2; }
__device__ __forceinline__ int v_rd_base(int lane) { return ((lane & 3) << 3) | (((lane >> 2) & 3) << 6) | (((lane >> 4) & 1) << 5) | (((lane >> 5) & 1) << 8); }
constexpr int v_rd_off(int d0, int ks, int half) { return d0 * 512 + ks * 4096 + half * 2048; }
template <int OFF> __device__ __forceinline__ s16x4 tr_read(int vb) {
  s16x4 r; asm volatile("ds_read_b64_tr_b16 %0, %1 offset:%2" : "=&v"(r) : "v"(vb), "i"(OFF) : "memory"); return r;
}
template <int D0> __device__ __forceinline__ void pv_one(f32x16& od, int vb, bf16x8 pa0, bf16x8 pa1, bf16x8 pa2, bf16x8 pa3) {
  const s16x4 l0 = tr_read<v_rd_off(D0, 0, 0)>(vb), h0 = tr_read<v_rd_off(D0, 0, 1)>(vb), l1 = tr_read<v_rd_off(D0, 1, 0)>(vb), h1 = tr_read<v_rd_off(D0, 1, 1)>(vb);
  const s16x4 l2 = tr_read<v_rd_off(D0, 2, 0)>(vb), h2 = tr_read<v_rd_off(D0, 2, 1)>(vb), l3 = tr_read<v_rd_off(D0, 3, 0)>(vb), h3 = tr_read<v_rd_off(D0, 3, 1)>(vb);
  asm volatile("s_waitcnt lgkmcnt(0)" ::: "memory"); ATT_SBAR();
#define ATT_PK(L, H) (bf16x8){L[0], L[1], L[2], L[3], H[0], H[1], H[2], H[3]}
  od = __builtin_amdgcn_mfma_f32_32x32x16_bf16(pa0, ATT_PK(l0, h0), od, 0, 0, 0);
  od = __builtin_amdgcn_mfma_f32_32x32x16_bf16(pa1, ATT_PK(l1, h1), od, 0, 0, 0);
  od = __builtin_amdgcn_mfma_f32_32x32x16_bf16(pa2, ATT_PK(l2, h2), od, 0, 0, 0);
  od = __builtin_amdgcn_mfma_f32_32x32x16_bf16(pa3, ATT_PK(l3, h3), od, 0, 0, 0);
#undef ATT_PK
}
template <int D0, int H> __device__ __forceinline__ void pv_half(f32x16& od, int vb, bf16x8 pa, bf16x8 pb) {
  const s16x4 l0 = tr_read<v_rd_off(D0, 2 * H, 0)>(vb), h0 = tr_read<v_rd_off(D0, 2 * H, 1)>(vb), l1 = tr_read<v_rd_off(D0, 2 * H + 1, 0)>(vb), h1 = tr_read<v_rd_off(D0, 2 * H + 1, 1)>(vb);
  asm volatile("s_waitcnt lgkmcnt(0)" ::: "memory"); ATT_SBAR();
#define ATT_PK(L, H_) (bf16x8){L[0], L[1], L[2], L[3], H_[0], H_[1], H_[2], H_[3]}
  od = __builtin_amdgcn_mfma_f32_32x32x16_bf16(pa, ATT_PK(l0, h0), od, 0, 0, 0);
  od = __builtin_amdgcn_mfma_f32_32x32x16_bf16(pb, ATT_PK(l1, h1), od, 0, 0, 0);
#undef ATT_PK
}
template <int D0> __device__ __forceinline__ void pv_rd(s16x4 (&v)[8], int vb) {
  v[0] = tr_read<v_rd_off(D0, 0, 0)>(vb); v[1] = tr_read<v_rd_off(D0, 0, 1)>(vb); v[2] = tr_read<v_rd_off(D0, 1, 0)>(vb); v[3] = tr_read<v_rd_off(D0, 1, 1)>(vb);
  v[4] = tr_read<v_rd_off(D0, 2, 0)>(vb); v[5] = tr_read<v_rd_off(D0, 2, 1)>(vb); v[6] = tr_read<v_rd_off(D0, 3, 0)>(vb); v[7] = tr_read<v_rd_off(D0, 3, 1)>(vb);
}
__device__ __forceinline__ void pv_mf(f32x16& od, const s16x4 (&v)[8], bf16x8 pa0, bf16x8 pa1, bf16x8 pa2, bf16x8 pa3) {
#define ATT_PK(L, H) (bf16x8){L[0], L[1], L[2], L[3], H[0], H[1], H[2], H[3]}
  od = __builtin_amdgcn_mfma_f32_32x32x16_bf16(pa0, ATT_PK(v[0], v[1]), od, 0, 0, 0);
  od = __builtin_amdgcn_mfma_f32_32x32x16_bf16(pa1, ATT_PK(v[2], v[3]), od, 0, 0, 0);
  od = __builtin_amdgcn_mfma_f32_32x32x16_bf16(pa2, ATT_PK(v[4], v[5]), od, 0, 0, 0);
  od = __builtin_amdgcn_mfma_f32_32x32x16_bf16(pa3, ATT_PK(v[6], v[7]), od, 0, 0, 0);
#undef ATT_PK
}
#define ATT_LGKM(n) do { asm volatile("s_waitcnt lgkmcnt(" #n ")" ::: "memory"); ATT_SBAR(); } while (0)
template <int D0, int H> __device__ __forceinline__ void pvh_rd(s16x4 (&v)[4], int vb) {
  v[0] = tr_read<v_rd_off(D0, 2 * H, 0)>(vb); v[1] = tr_read<v_rd_off(D0, 2 * H, 1)>(vb); v[2] = tr_read<v_rd_off(D0, 2 * H + 1, 0)>(vb); v[3] = tr_read<v_rd_off(D0, 2 * H + 1, 1)>(vb);
}
__device__ __forceinline__ void pvh_mf(f32x16& od, const s16x4 (&v)[4], bf16x8 pa, bf16x8 pb) {
#define ATT_PK(L, H_) (bf16x8){L[0], L[1], L[2], L[3], H_[0], H_[1], H_[2], H_[3]}
  od = __builtin_amdgcn_mfma_f32_32x32x16_bf16(pa, ATT_PK(v[0], v[1]), od, 0, 0, 0);
  od = __builtin_amdgcn_mfma_f32_32x32x16_bf16(pb, ATT_PK(v[2], v[3]), od, 0, 0, 0);
#undef ATT_PK
}
__device__ __forceinline__ void pv_d0(f32x16* o, int vb, bf16x8 pa0, bf16x8 pa1, bf16x8 pa2, bf16x8 pa3) {
  pv_one<0>(o[0], vb, pa0, pa1, pa2, pa3); pv_one<1>(o[1], vb, pa0, pa1, pa2, pa3); pv_one<2>(o[2], vb, pa0, pa1, pa2, pa3); pv_one<3>(o[3], vb, pa0, pa1, pa2, pa3);
}

__device__ __forceinline__ float sm_rowmax(const f32x16& p0, const f32x16& p1) {
  float a = fmaxf(fmaxf(p0[0], p0[1]), p1[0]), b = fmaxf(fmaxf(p0[2], p0[3]), p1[1]); a = fmaxf(fmaxf(a, p1[2]), p1[3]);
#pragma unroll
  for (int r = 4; r < 16; r += 4) { a = fmaxf(fmaxf(a, p0[r]), p0[r + 1]); b = fmaxf(fmaxf(b, p0[r + 2]), p0[r + 3]); a = fmaxf(fmaxf(a, p1[r]), p1[r + 1]); b = fmaxf(fmaxf(b, p1[r + 2]), p1[r + 3]); }
  float pmax = fmaxf(a, b);
  auto rr = __builtin_amdgcn_permlane32_swap(__float_as_uint(pmax), __float_as_uint(pmax), false, false);
  return fmaxf(__uint_as_float(rr[0]), __uint_as_float(rr[1]));
}
__device__ __forceinline__ void sm_decide(float pmax, float& m_reg, float& mn, float& alpha) {
  if (__builtin_expect(__all(pmax - m_reg <= THR), 1)) { mn = m_reg; alpha = 1.f; }
  else { mn = fmaxf(m_reg, pmax); alpha = __builtin_amdgcn_exp2f(m_reg - mn); m_reg = mn; }
}
template <int LO, int HI> __device__ __forceinline__ void sm_sub(f32x16& p, float mn) {
#pragma unroll
  for (int r = LO; r < HI; ++r) p[r] = p[r] - mn;
}
template <int LO, int HI> __device__ __forceinline__ void sm_exp(f32x16& p) {
#pragma unroll
  for (int r = LO; r < HI; ++r) p[r] = __builtin_amdgcn_exp2f(p[r]);
}
__device__ __forceinline__ float fadd_s(float a, float b) { float r; asm("v_add_f32_e32 %0, %1, %2" : "=v"(r) : "v"(a), "v"(b)); return r; }
__device__ __forceinline__ void sm_sum(const f32x16& p0, const f32x16& p1, float alpha, float& l_reg) {
  float s0 = fadd_s(p0[0], p0[1]), s1 = fadd_s(p1[0], p1[1]);
#pragma unroll
  for (int r = 2; r < 16; ++r) { s0 = fadd_s(s0, p0[r]); s1 = fadd_s(s1, p1[r]); }
  float ps = s0 + s1;
  auto rr = __builtin_amdgcn_permlane32_swap(__float_as_uint(ps), __float_as_uint(ps), false, false);
  ps = __uint_as_float(rr[0]) + __uint_as_float(rr[1]);
  l_reg = l_reg * alpha + ps;
}
template <int BASE> __device__ __forceinline__ bf16x8 sm_pack(const f32x16& P) {
  const unsigned a0 = cvtpk(P[BASE + 0], P[BASE + 1]), a1 = cvtpk(P[BASE + 2], P[BASE + 3]), b0 = cvtpk(P[BASE + 4], P[BASE + 5]), b1 = cvtpk(P[BASE + 6], P[BASE + 7]);
  auto r0 = __builtin_amdgcn_permlane32_swap(a0, b0, false, false); auto r1 = __builtin_amdgcn_permlane32_swap(a1, b1, false, false);
  u32x4 w = {r0[0], r1[0], r0[1], r1[1]}; return *reinterpret_cast<bf16x8*>(&w);
}
template <int DQK> struct AttnCfg { static constexpr int SHM_V = KVBLK * 128 * 2, SHM_K = KVBLK * DQK * 2, NKB = SHM_K / 8192, SHM = 2 * SHM_V + 2 * SHM_K + NW * 64 * 4; };
typedef __attribute__((address_space(3))) unsigned char* ldsp_t;
template <int DQK, bool FAST>
__device__ __forceinline__ void attn_unit(const bf16* __restrict__ Qb, int ldq, const bf16* __restrict__ Kc, const bf16* __restrict__ Kl, int ldk,
                                          const bf16* __restrict__ Vc, const bf16* __restrict__ Vl, int ldv, bf16* __restrict__ Ob, int ldo, int NT, int nt_c, ldsp_t lds) {
  constexpr int SHM_V = AttnCfg<DQK>::SHM_V, SHM_K = AttnCfg<DQK>::SHM_K, NKB = AttnCfg<DQK>::NKB, NKC = DQK / 16, CPR = DQK / 8;
  const int tid = threadIdx.x, wid = __builtin_amdgcn_readfirstlane(tid >> 6), lane = tid & 63, r32 = lane & 31, hi = lane >> 5;
  const ldsp_t V_lds = lds; const ldsp_t K_lds = lds + 2 * SHM_V;
  __attribute__((address_space(3))) float* ws = (__attribute__((address_space(3))) float*)(lds + 122880) + wid * 64;
  __attribute__((address_space(3))) float* li_l = ws; __attribute__((address_space(3))) float* al_l = ws + 32;
  float m_reg = -1e30f, l_reg = 0; f32x16 o[4] = {}; bf16x8 qr[NKC];
  const bf16* Qw = Qb + (long)(wid * QBLK + r32) * ldq + hi * 8;
#pragma unroll
  for (int d0 = 0; d0 < NKC; ++d0) qr[d0] = *reinterpret_cast<const bf16x8*>(Qw + d0 * 16);
  const int vb0 = (int)(unsigned)(uintptr_t)V_lds + v_rd_base(lane);
  int koff[NKB], voff[2];
#pragma unroll
  for (int i = 0; i < NKB; ++i) { const int s_ = (wid + 8 * i) * 64 + lane, row_ = s_ / CPR, chp_ = s_ % CPR; koff[i] = row_ * ldk + ((chp_ ^ ((row_ >> 1) & 7)) << 3); }
#pragma unroll
  for (int i = 0; i < 2; ++i) { const int s_ = (wid + 8 * i) * 64 + lane, sub_ = s_ >> 5, kk_ = ((sub_ >> 2) << 3) | ((s_ >> 2) & 7), c_ = ((sub_ & 3) << 5) | ((s_ & 3) << 3);
    const int k_ = (kk_ & ~0xC) | ((kk_ & 4) << 1) | ((kk_ & 8) >> 1); voff[i] = k_ * ldv + c_; }
#define ATT_DMA(t, b) do { const int t_ = (t); const bool c_ = t_ < nt_c; const long k0_ = c_ ? (long)t_ * KVBLK : (long)(t_ - nt_c) * KVBLK; \
    const bf16* Kb_ = (c_ ? Kc : Kl) + k0_ * ldk; const bf16* Vb_ = (c_ ? Vc : Vl) + k0_ * ldv; \
    _Pragma("unroll") for (int i_ = 0; i_ < NKB; ++i_) __builtin_amdgcn_global_load_lds((const unsigned*)(Kb_ + koff[i_]), (__attribute__((address_space(3))) unsigned*)(K_lds + (b) * SHM_K + (wid + 8 * i_) * 1024), 16, 0, 0); \
    _Pragma("unroll") for (int i_ = 0; i_ < 2; ++i_) __builtin_amdgcn_global_load_lds((const unsigned*)(Vb_ + voff[i_]), (__attribute__((address_space(3))) unsigned*)(V_lds + (b) * SHM_V + (wid + 8 * i_) * 1024), 16, 0, 0); } while (0)
#define ATT_RESC(a) do { if (__any((a) < 1.f)) { if (hi == 0) al_l[r32] = (a); asm volatile("s_waitcnt lgkmcnt(0)" ::: "memory"); \
    _Pragma("unroll") for (int d = 0; d < 4; ++d) _Pragma("unroll") for (int r = 0; r < 16; ++r) o[d][r] *= al_l[crow(r, hi)]; } } while (0)
  bf16x8 pa0, pa1, pa2, pa3; f32x16 p0, p1; float mn, al;
  ATT_DMA(0, 0);
  asm volatile("s_waitcnt vmcnt(0)" ::: "memory"); __syncthreads();
  for (int j = 0; j < NT; ++j) {
    const int cur = j & 1;
    if (j + 1 < NT) { ATT_DMA(j + 1, cur ^ 1); }
    if constexpr (FAST) {
      const ldsp_t Kb_ = K_lds + cur * SHM_K; const int vbb = vb0 + cur * SHM_V;
      ATT_SBAR(); p0 = f32x16{};
#pragma unroll
      for (int d0 = 0; d0 < NKC; ++d0) { p0 = __builtin_amdgcn_mfma_f32_32x32x16_bf16(*(const __attribute__((address_space(3))) bf16x8*)(Kb_ + kswz<DQK>(r32, (d0 * 16 + hi * 8) * 2)), qr[d0], p0, 0, 0, 0); }
      ATT_SBAR(); p1 = f32x16{};
#pragma unroll
      for (int d0 = 0; d0 < NKC; ++d0) { p1 = __builtin_amdgcn_mfma_f32_32x32x16_bf16(*(const __attribute__((address_space(3))) bf16x8*)(Kb_ + kswz<DQK>(32 + r32, (d0 * 16 + hi * 8) * 2)), qr[d0], p1, 0, 0, 0); }
      sm_exp<0, 16>(p0); pa0 = sm_pack<0>(p0); pa1 = sm_pack<8>(p0);
      ATT_SBAR();
      s16x4 va_[4], vb2_[4];
      pvh_rd<0, 0>(va_, vbb); pvh_rd<1, 0>(vb2_, vbb); ATT_LGKM(4); pvh_mf(o[0], va_, pa0, pa1); sm_exp<0, 4>(p1); ATT_SBAR();
      pvh_rd<2, 0>(va_, vbb); ATT_LGKM(4); pvh_mf(o[1], vb2_, pa0, pa1); sm_exp<4, 8>(p1); ATT_SBAR();
      pvh_rd<3, 0>(vb2_, vbb); ATT_LGKM(4); pvh_mf(o[2], va_, pa0, pa1); sm_exp<8, 12>(p1); ATT_SBAR();
      pvh_rd<0, 1>(va_, vbb); ATT_LGKM(4); pvh_mf(o[3], vb2_, pa0, pa1); sm_exp<12, 16>(p1); sm_sum(p0, p1, 1.f, l_reg); pa2 = sm_pack<0>(p1); pa3 = sm_pack<8>(p1); ATT_SBAR();
      pvh_rd<1, 1>(vb2_, vbb); ATT_LGKM(4); pvh_mf(o[0], va_, pa2, pa3); ATT_SBAR();
      pvh_rd<2, 1>(va_, vbb); ATT_LGKM(4); pvh_mf(o[1], vb2_, pa2, pa3); ATT_SBAR();
      pvh_rd<3, 1>(vb2_, vbb); ATT_LGKM(4); pvh_mf(o[2], va_, pa2, pa3); ATT_SBAR();
      ATT_LGKM(0); pvh_mf(o[3], vb2_, pa2, pa3);
    } else {
    ATT_SBAR(); qkt<DQK>(p0, p1, K_lds + cur * SHM_K, qr, r32, hi);
    partialSM(p0, p1, m_reg, mn, al); ATT_RESC(al);
    finishSM(p0, p1, al, l_reg, pa0, pa1, pa2, pa3); ATT_SBAR();
    pv_d0(o, vb0 + cur * SHM_V, pa0, pa1, pa2, pa3);
    }
    asm volatile("s_waitcnt vmcnt(0)" ::: "memory"); __syncthreads();
  }
  if (hi == 0) li_l[r32] = l_reg; asm volatile("s_waitcnt lgkmcnt(0)" ::: "memory");
  float rli[16];
#pragma unroll
  for (int r = 0; r < 16; ++r) rli[r] = __builtin_amdgcn_rcpf(li_l[crow(r, hi)]);
  { __attribute__((address_space(3))) unsigned short* stg = (__attribute__((address_space(3))) unsigned short*)(lds) + wid * (32 * 136);
#pragma unroll
    for (int r = 0; r < 16; ++r) { const int orow = crow(r, hi);
#pragma unroll
      for (int d0 = 0; d0 < 4; ++d0) stg[orow * 136 + d0 * 32 + r32] = (unsigned short)(cvtpk(o[d0][r] * rli[r], 0.f) & 0xffffu); }
    asm volatile("s_waitcnt lgkmcnt(0)" ::: "memory");
    bf16* Ow = Ob + (long)(wid * QBLK) * ldo;
#pragma unroll
    for (int i = 0; i < 8; ++i) { const int row = i * 4 + (lane >> 4), ch = lane & 15; const u32x4 v = *(const __attribute__((address_space(3))) u32x4*)(stg + row * 136 + ch * 8); *(u32x4*)(Ow + (long)row * ldo + ch * 8) = v; } }
  __syncthreads();
#undef ATT_DMA
#undef ATT_RESC
}
template <int DQK, bool FAST>
__device__ __forceinline__ void attn_unit_pipe(const bf16* __restrict__ Qb, int ldq, const bf16* __restrict__ Kc, const bf16* __restrict__ Kl, int ldk,
                                          const bf16* __restrict__ Vc, const bf16* __restrict__ Vl, int ldv, bf16* __restrict__ Ob, int ldo, int NT, int nt_c, ldsp_t lds) {
  constexpr int SHM_V = AttnCfg<DQK>::SHM_V, SHM_K = AttnCfg<DQK>::SHM_K, NKB = AttnCfg<DQK>::NKB, NKC = DQK / 16, CPR = DQK / 8;
  const int tid = threadIdx.x, wid = __builtin_amdgcn_readfirstlane(tid >> 6), lane = tid & 63, r32 = lane & 31, hi = lane >> 5;
  const ldsp_t V_lds = lds; const ldsp_t K_lds = lds + 2 * SHM_V;
  __attribute__((address_space(3))) float* ws = (__attribute__((address_space(3))) float*)(lds + 122880) + wid * 64;
  __attribute__((address_space(3))) float* li_l = ws; __attribute__((address_space(3))) float* al_l = ws + 32;
  float m_reg = -1e30f, l_reg = 0; f32x16 o[4] = {}; bf16x8 qr[NKC];
  const bf16* Qw = Qb + (long)(wid * QBLK + r32) * ldq + hi * 8;
#pragma unroll
  for (int d0 = 0; d0 < NKC; ++d0) qr[d0] = *reinterpret_cast<const bf16x8*>(Qw + d0 * 16);
  const int vb0 = (int)(unsigned)(uintptr_t)V_lds + v_rd_base(lane);
  int koff[NKB], voff[2];
#pragma unroll
  for (int i = 0; i < NKB; ++i) { const int s_ = (wid + 8 * i) * 64 + lane, row_ = s_ / CPR, chp_ = s_ % CPR; koff[i] = row_ * ldk + ((chp_ ^ ((row_ >> 1) & 7)) << 3); }
#pragma unroll
  for (int i = 0; i < 2; ++i) { const int s_ = (wid + 8 * i) * 64 + lane, sub_ = s_ >> 5, kk_ = ((sub_ >> 2) << 3) | ((s_ >> 2) & 7), c_ = ((sub_ & 3) << 5) | ((s_ & 3) << 3);
    const int k_ = (kk_ & ~0xC) | ((kk_ & 4) << 1) | ((kk_ & 8) >> 1); voff[i] = k_ * ldv + c_; }
#define ATT_DMA(t, b) do { const int t_ = (t); const bool c_ = t_ < nt_c; const long k0_ = c_ ? (long)t_ * KVBLK : (long)(t_ - nt_c) * KVBLK; \
    const bf16* Kb_ = (c_ ? Kc : Kl) + k0_ * ldk; const bf16* Vb_ = (c_ ? Vc : Vl) + k0_ * ldv; \
    _Pragma("unroll") for (int i_ = 0; i_ < NKB; ++i_) __builtin_amdgcn_global_load_lds((const unsigned*)(Kb_ + koff[i_]), (__attribute__((address_space(3))) unsigned*)(K_lds + (b) * SHM_K + (wid + 8 * i_) * 1024), 16, 0, 0); \
    _Pragma("unroll") for (int i_ = 0; i_ < 2; ++i_) __builtin_amdgcn_global_load_lds((const unsigned*)(Vb_ + voff[i_]), (__attribute__((address_space(3))) unsigned*)(V_lds + (b) * SHM_V + (wid + 8 * i_) * 1024), 16, 0, 0); } while (0)
#define ATT_RESC(a) do { if (__any((a) < 1.f)) { if (hi == 0) al_l[r32] = (a); asm volatile("s_waitcnt lgkmcnt(0)" ::: "memory"); \
    _Pragma("unroll") for (int d = 0; d < 4; ++d) _Pragma("unroll") for (int r = 0; r < 16; ++r) o[d][r] *= al_l[crow(r, hi)]; } } while (0)
  bf16x8 pa0, pa1, pa2, pa3; f32x16 pA0, pA1, pB0, pB1; float mnA, mnB, alA, alB;
#define ATT_DMAK(t, b) do { const int t_ = (t); const bool c_ = t_ < nt_c; const long k0_ = c_ ? (long)t_ * KVBLK : (long)(t_ - nt_c) * KVBLK; const bf16* Kb_ = (c_ ? Kc : Kl) + k0_ * ldk; \
    _Pragma("unroll") for (int i_ = 0; i_ < NKB; ++i_) __builtin_amdgcn_global_load_lds((const unsigned*)(Kb_ + koff[i_]), (__attribute__((address_space(3))) unsigned*)(K_lds + (b) * SHM_K + (wid + 8 * i_) * 1024), 16, 0, 0); } while (0)
#define ATT_DMAV(t, b) do { const int t_ = (t); const bool c_ = t_ < nt_c; const long k0_ = c_ ? (long)t_ * KVBLK : (long)(t_ - nt_c) * KVBLK; const bf16* Vb_ = (c_ ? Vc : Vl) + k0_ * ldv; \
    _Pragma("unroll") for (int i_ = 0; i_ < 2; ++i_) __builtin_amdgcn_global_load_lds((const unsigned*)(Vb_ + voff[i_]), (__attribute__((address_space(3))) unsigned*)(V_lds + (b) * SHM_V + (wid + 8 * i_) * 1024), 16, 0, 0); } while (0)
#define ATT_ENDSTEP() do { asm volatile("s_waitcnt vmcnt(0)" ::: "memory"); __syncthreads(); } while (0)
  static_assert(DQK == 64, "the hand-interleaved step is written for a 64-wide QK");
#define ATT_KF(kb, d0, h) (*(const __attribute__((address_space(3))) bf16x8*)(K_lds + (kb) * SHM_K + kswz<DQK>((h) * 32 + r32, ((d0) * 16 + hi * 8) * 2)))
#define ATT_STEP(C0, C1, alC, mnC, P0, P1, alP, kb, vb) do { \
    bf16x8 kf_[8]; _Pragma("unroll") for (int d_ = 0; d_ < 4; ++d_) { kf_[2 * d_] = ATT_KF(kb, d_, 0); kf_[2 * d_ + 1] = ATT_KF(kb, d_, 1); } \
    C0 = f32x16{}; C1 = f32x16{}; \
    ATT_SBAR(); \
    C0 = __builtin_amdgcn_mfma_f32_32x32x16_bf16(kf_[0], qr[0], C0, 0, 0, 0); C1 = __builtin_amdgcn_mfma_f32_32x32x16_bf16(kf_[1], qr[0], C1, 0, 0, 0); sm_exp<0, 8>(P1); ATT_SBAR(); \
    C0 = __builtin_amdgcn_mfma_f32_32x32x16_bf16(kf_[2], qr[1], C0, 0, 0, 0); C1 = __builtin_amdgcn_mfma_f32_32x32x16_bf16(kf_[3], qr[1], C1, 0, 0, 0); sm_exp<8, 16>(P1); ATT_SBAR(); \
    C0 = __builtin_amdgcn_mfma_f32_32x32x16_bf16(kf_[4], qr[2], C0, 0, 0, 0); C1 = __builtin_amdgcn_mfma_f32_32x32x16_bf16(kf_[5], qr[2], C1, 0, 0, 0); sm_sum(P0, P1, alP, l_reg); pa0 = sm_pack<0>(P0); ATT_SBAR(); \
    C0 = __builtin_amdgcn_mfma_f32_32x32x16_bf16(kf_[6], qr[3], C0, 0, 0, 0); C1 = __builtin_amdgcn_mfma_f32_32x32x16_bf16(kf_[7], qr[3], C1, 0, 0, 0); pa1 = sm_pack<8>(P0); pa2 = sm_pack<0>(P1); pa3 = sm_pack<8>(P1); ATT_SBAR(); \
    if constexpr (FAST) { \
    const int vbb_ = vb0 + (vb) * SHM_V; s16x4 va_[8], vb2_[8]; \
    pv_rd<0>(va_, vbb_); pv_rd<1>(vb2_, vbb_); ATT_LGKM(8); pv_mf(o[0], va_, pa0, pa1, pa2, pa3); sm_exp<0, 4>(C0); ATT_SBAR(); \
    pv_rd<2>(va_, vbb_); ATT_LGKM(8); pv_mf(o[1], vb2_, pa0, pa1, pa2, pa3); sm_exp<4, 8>(C0); ATT_SBAR(); \
    pv_rd<3>(vb2_, vbb_); ATT_LGKM(8); pv_mf(o[2], va_, pa0, pa1, pa2, pa3); sm_exp<8, 12>(C0); ATT_SBAR(); \
    ATT_LGKM(0); pv_mf(o[3], vb2_, pa0, pa1, pa2, pa3); sm_exp<12, 16>(C0); ATT_SBAR(); alC = 1.f; \
    } else { \
    pv_one<0>(o[0], vb0 + (vb) * SHM_V, pa0, pa1, pa2, pa3); float pm_ = sm_rowmax(C0, C1); sm_decide(pm_, m_reg, mnC, alC); \
    pv_one<1>(o[1], vb0 + (vb) * SHM_V, pa0, pa1, pa2, pa3); sm_sub<0, 16>(C0, mnC); sm_sub<0, 16>(C1, mnC); \
    pv_one<2>(o[2], vb0 + (vb) * SHM_V, pa0, pa1, pa2, pa3); sm_exp<0, 8>(C0); \
    pv_one<3>(o[3], vb0 + (vb) * SHM_V, pa0, pa1, pa2, pa3); sm_exp<8, 16>(C0); ATT_SBAR(); \
    ATT_RESC(alC); } } while (0)
  ATT_DMAK(0, 0); ATT_DMAV(0, 0); ATT_ENDSTEP();
  ATT_DMAK(1, 1);
  qkt<DQK>(pA0, pA1, K_lds, qr, r32, hi);
  if constexpr (FAST) { sm_exp<0, 16>(pA0); alA = 1.f; mnA = 0.f; mnB = 0.f; alB = 1.f; } else { partialSM(pA0, pA1, m_reg, mnA, alA); }
  ATT_ENDSTEP();
  ATT_DMAK(2, 0); ATT_DMAV(1, 1);
  ATT_STEP(pB0, pB1, alB, mnB, pA0, pA1, alA, 1, 0);
  ATT_ENDSTEP();
  for (int j = 2; j < NT; j += 2) {
    if (j + 1 < NT) { ATT_DMAK(j + 1, 1); } ATT_DMAV(j, 0);
    ATT_STEP(pA0, pA1, alA, mnA, pB0, pB1, alB, 0, 1);
    ATT_ENDSTEP();
    if (j + 2 < NT) { ATT_DMAK(j + 2, 0); } ATT_DMAV(j + 1, 1);
    ATT_STEP(pB0, pB1, alB, mnB, pA0, pA1, alA, 1, 0);
    ATT_ENDSTEP();
  }
  finishSM(pB0, pB1, alB, l_reg, pa0, pa1, pa2, pa3); ATT_SBAR();
  pv_d0(o, vb0 + SHM_V, pa0, pa1, pa2, pa3);
  __syncthreads();
#undef ATT_STEP
#undef ATT_KF
#undef ATT_DMAK
#undef ATT_DMAV
#undef ATT_ENDSTEP
  if (hi == 0) li_l[r32] = l_reg; asm volatile("s_waitcnt lgkmcnt(0)" ::: "memory");
  float rli[16];
#pragma unroll
  for (int r = 0; r < 16; ++r) rli[r] = __builtin_amdgcn_rcpf(li_l[crow(r, hi)]);
  { __attribute__((address_space(3))) unsigned short* stg = (__attribute__((address_space(3))) unsigned short*)(lds) + wid * (32 * 136);
#pragma unroll
    for (int r = 0; r < 16; ++r) { const int orow = crow(r, hi);
#pragma unroll
      for (int d0 = 0; d0 < 4; ++d0) stg[orow * 136 + d0 * 32 + r32] = (unsigned short)(cvtpk(o[d0][r] * rli[r], 0.f) & 0xffffu); }
    asm volatile("s_waitcnt lgkmcnt(0)" ::: "memory");
    bf16* Ow = Ob + (long)(wid * QBLK) * ldo;
#pragma unroll
    for (int i = 0; i < 8; ++i) { const int row = i * 4 + (lane >> 4), ch = lane & 15; const u32x4 v = *(const __attribute__((address_space(3))) u32x4*)(stg + row * 136 + ch * 8); *(u32x4*)(Ow + (long)row * ldo + ch * 8) = v; } }
  __syncthreads();
#undef ATT_DMA
#undef ATT_RESC
}
}
constexpr float LOG2E = 1.4426950408889634f;
__device__ __forceinline__ void rope_table_phase(Frame& F, const Args& a) {
    float* RC = (float*)(a.ws + WS_ROPE); float* RS = RC + SEQ * 32;
    for (int i = blockIdx.x * (NWAVES * 64) + F.tid; i < SEQ * 32; i += F.G * NWAVES * 64) {
        const int t = i >> 5, p = i & 31;
        const float inv = powf(10000.0f, -(float)(p & 15) / 16.0f);
        const float ang = (float)(p < 16 ? (t >> 6) : (t & 63)) * inv;
        RC[i] = cosf(ang); RS[i] = sinf(ang);
    }
}
__device__ __forceinline__ void unpack8(const v4u w, float* x) {
    x[0] = __uint_as_float(w.x << 16); x[1] = __uint_as_float(w.x & 0xffff0000u); x[2] = __uint_as_float(w.y << 16); x[3] = __uint_as_float(w.y & 0xffff0000u);
    x[4] = __uint_as_float(w.z << 16); x[5] = __uint_as_float(w.z & 0xffff0000u); x[6] = __uint_as_float(w.w << 16); x[7] = __uint_as_float(w.w & 0xffff0000u);
}
__device__ __forceinline__ v4u pack8(const float* x) { v4u w; w.x = pk2(x[0], x[1]); w.y = pk2(x[2], x[3]); w.z = pk2(x[4], x[5]); w.w = pk2(x[6], x[7]); return w; }
__device__ __forceinline__ void prep1_phase(Frame& F, const Args& a, int l) {
    bf16* PROJ = (bf16*)(a.ws + WS_PROJ);
    const float* RC = (const float*)(a.ws + WS_ROPE); const float* RS = RC + SEQ * 32;
    const float* gqc = a.in[I_QCN] + l * 512; const float* gkvc = a.in[I_KVCN] + l * 256;
    const float* gdq = a.in[I_DQN] + l * 64; const float* gdk = a.in[I_DKN] + l * 64;
    const int gw = blockIdx.x * NWAVES + F.wave, NGW = F.G * NWAVES, lane = F.lane;
    const bool isq = lane < 32;
    const f32x4 gq0 = *(const f32x4*)(gqc + lane * 8), gq1 = *(const f32x4*)(gqc + lane * 8 + 4), gkv = *(const f32x4*)(gkvc + lane * 4);
    f32x4 gnv[8];
#pragma unroll
    for (int c = 0; c < 8; ++c) gnv[c] = *(const f32x4*)((isq ? gdq : gdk) + (lane & 1) * 32 + c * 4);
#define P1_LOAD(m_, QC, KV, D) do { const bf16* r_ = PROJ + (size_t)(m_) * NPROJ; QC = *(const v4u*)(r_ + PC_QC + lane * 8); KV = *(const unsigned long long*)(r_ + PC_KVC + lane * 4); \
        _Pragma("unroll") for (int c_ = 0; c_ < 4; ++c_) D[c_] = *(const v4u*)(r_ + PC_DQ + lane * 32 + c_ * 8); } while (0)
    v4u n_qc = {}, n_d[4] = {}; unsigned long long n_kv = 0;
    if (gw < T) P1_LOAD(gw, n_qc, n_kv, n_d);
    for (int m = gw; m < T; m += NGW) {
        bf16* row = PROJ + (size_t)m * NPROJ;
        const bool isl = m < TL; const int t = m & (SEQ - 1);
        const v4u c_qc = n_qc; const unsigned long long c_kv = n_kv; v4u c_d[4];
#pragma unroll
        for (int c = 0; c < 4; ++c) c_d[c] = n_d[c];
        if (m + NGW < T) P1_LOAD(m + NGW, n_qc, n_kv, n_d);
        f32x4 cs[8], sn[8];
        if (isl) {
#pragma unroll
            for (int c = 0; c < 8; ++c) { cs[c] = *(const f32x4*)(RC + (size_t)t * 32 + c * 4); sn[c] = *(const f32x4*)(RS + (size_t)t * 32 + c * 4); }
        }
        { float x[8]; unpack8(c_qc, x); float ss = 0.f;
#pragma unroll
          for (int i = 0; i < 8; ++i) ss += x[i] * x[i];
          const float rstd = 1.0f / sqrtf(wave_sum(ss) * (1.f / 512.f) + EPSN);
#pragma unroll
          for (int i = 0; i < 4; ++i) { x[i] = x[i] * rstd * gq0[i]; x[4 + i] = x[4 + i] * rstd * gq1[i]; }
          *(v4u*)(row + PC_QC + lane * 8) = pack8(x); }
        { const unsigned long long raw = c_kv; const unsigned lo32 = (unsigned)raw, hi32 = (unsigned)(raw >> 32);
          float x0 = __uint_as_float(lo32 << 16), x1 = __uint_as_float(lo32 & 0xffff0000u), x2 = __uint_as_float(hi32 << 16), x3 = __uint_as_float(hi32 & 0xffff0000u);
          const float rstd = 1.0f / sqrtf(wave_sum(x0 * x0 + x1 * x1 + x2 * x2 + x3 * x3) * (1.f / 256.f) + EPSN);
          *(unsigned long long*)(row + PC_KVC + lane * 4) = (unsigned long long)pk2(x0 * rstd * gkv.x, x1 * rstd * gkv.y) | ((unsigned long long)pk2(x2 * rstd * gkv.z, x3 * rstd * gkv.w) << 32); }
        {
            static_assert(PC_DK == PC_DQ + 1024, "dq and dk adjacent");
            bf16* p = row + PC_DQ + lane * 32;
            const float osc = isq ? 0.125f * LOG2E : 1.0f;
            float x[32];
#pragma unroll
            for (int c = 0; c < 4; ++c) unpack8(c_d[c], x + c * 8);
            float ss = 0.f;
#pragma unroll
            for (int i = 0; i < 32; ++i) ss += x[i] * x[i];
            ss += __shfl_xor(ss, 1);
            const float rstd = 1.0f / sqrtf(ss * (1.f / 64.f) + EPSN);
#pragma unroll
            for (int c = 0; c < 8; ++c) {
#pragma unroll
                for (int i = 0; i < 4; ++i) x[c * 4 + i] = x[c * 4 + i] * rstd * gnv[c][i]; }
            if (isl) {
                const bool second = (lane & 1) != 0;
#pragma unroll
                for (int c = 0; c < 8; ++c) {
#pragma unroll
                    for (int i = 0; i < 4; ++i) { const float mine = x[c * 4 + i], other = __shfl_xor(mine, 1);
                        x[c * 4 + i] = second ? (other * sn[c][i] + mine * cs[c][i]) : (mine * cs[c][i] - other * sn[c][i]); } }
            }
#pragma unroll
            for (int i = 0; i < 32; ++i) x[i] *= osc;
#pragma unroll
            for (int c = 0; c < 4; ++c) *(v4u*)(p + c * 8) = pack8(x + c * 8);
        }
    }
#undef P1_LOAD
}
__device__ __forceinline__ void prep2_phase(Frame& F, const Args& a, int l) {
    bf16* PROJ = (bf16*)(a.ws + WS_PROJ); bf16* QRAW = (bf16*)(a.ws + WS_QRAW); bf16* KVRAW = (bf16*)(a.ws + WS_KVRAW); bf16* KN = (bf16*)(a.ws + WS_KN);
    const float* RC = (const float*)(a.ws + WS_ROPE); const float* RS = RC + SEQ * 32;
    const float* gq = a.in[I_QN] + l * 192; const float* gk = a.in[I_KN] + l * 192;
    const int gw = blockIdx.x * NWAVES + F.wave, NGW = F.G * NWAVES, lane = F.lane, h = lane >> 3, sub = lane & 7;
    const float qsc = 0.07216878364870322f * LOG2E;
    f32x4 gqn[4], gqr[2], gkn[4], gkr[2];
#pragma unroll
    for (int c = 0; c < 4; ++c) { gqn[c] = *(const f32x4*)(gq + sub * 16 + c * 4); gkn[c] = *(const f32x4*)(gk + sub * 16 + c * 4); }
#pragma unroll
    for (int c = 0; c < 2; ++c) { gqr[c] = *(const f32x4*)(gq + 128 + sub * 8 + c * 4); gkr[c] = *(const f32x4*)(gk + 128 + sub * 8 + c * 4); }
#define P2_LOAD(m_, R) do { const bf16* q_ = QRAW + (size_t)(m_) * 1536 + h * 192; const bf16* k_ = KVRAW + (size_t)(m_) * 2048 + h * 256 + sub * 16; \
        R[0] = *(const v4u*)(q_ + sub * 16); R[1] = *(const v4u*)(q_ + sub * 16 + 8); R[2] = *(const v4u*)(q_ + 128 + sub * 8); \
        R[3] = *(const v4u*)(k_); R[4] = *(const v4u*)(k_ + 8); R[5] = *(const v4u*)(PROJ + (size_t)(m_) * NPROJ + PC_KR + sub * 8); } while (0)
    v4u nx[6] = {};
    if (gw < T) P2_LOAD(gw, nx);
    for (int m = gw; m < T; m += NGW) {
        const bool isl = m < TL; const int t = m & (SEQ - 1);
        v4u cur[6];
#pragma unroll
        for (int i = 0; i < 6; ++i) cur[i] = nx[i];
        if (m + NGW < T) P2_LOAD(m + NGW, nx);
        const int pi = (sub & 3) * 8;
        f32x4 cs[2], sn[2];
        if (isl) {
#pragma unroll
            for (int c = 0; c < 2; ++c) { cs[c] = *(const f32x4*)(RC + (size_t)t * 32 + pi + c * 4); sn[c] = *(const f32x4*)(RS + (size_t)t * 32 + pi + c * 4); }
        }
#pragma unroll
        for (int w = 0; w < 2; ++w) {
            bf16* on = (w == 0 ? QRAW : KN) + (size_t)m * 1536 + h * 192 + sub * 16;
            bf16* orp = (w == 0 ? QRAW : KN) + (size_t)m * 1536 + h * 192 + 128 + sub * 8;
            float xn[16], xr[8];
            unpack8(cur[3 * w], xn); unpack8(cur[3 * w + 1], xn + 8); unpack8(cur[3 * w + 2], xr);
            float ss = 0.f;
#pragma unroll
            for (int i = 0; i < 16; ++i) ss += xn[i] * xn[i];
#pragma unroll
            for (int i = 0; i < 8; ++i) ss += xr[i] * xr[i];
            ss += __shfl_xor(ss, 1); ss += __shfl_xor(ss, 2); ss += __shfl_xor(ss, 4);
            const float rstd = 1.0f / sqrtf(ss * (1.f / 192.f) + EPSN);
            const float osc = w == 0 ? qsc : 1.0f;
#pragma unroll
            for (int c = 0; c < 4; ++c) { const f32x4 gv = w == 0 ? gqn[c] : gkn[c];
#pragma unroll
                for (int i = 0; i < 4; ++i) xn[c * 4 + i] = xn[c * 4 + i] * rstd * gv[i] * osc; }
#pragma unroll
            for (int c = 0; c < 2; ++c) { const f32x4 gv = w == 0 ? gqr[c] : gkr[c];
#pragma unroll
                for (int i = 0; i < 4; ++i) xr[c * 4 + i] = xr[c * 4 + i] * rstd * gv[i]; }
            if (isl) {
                const bool second = (sub & 4) != 0;
#pragma unroll
                for (int c = 0; c < 2; ++c) {
#pragma unroll
                    for (int i = 0; i < 4; ++i) { const float mine = xr[c * 4 + i], other = __shfl_xor(mine, 4);
                        xr[c * 4 + i] = second ? (other * sn[c][i] + mine * cs[c][i]) : (mine * cs[c][i] - other * sn[c][i]); } }
            }
#pragma unroll
            for (int i = 0; i < 8; ++i) xr[i] *= osc;
            *(v4u*)(on) = pack8(xn); *(v4u*)(on + 8) = pack8(xn + 8); *(v4u*)(orp) = pack8(xr);
        }
    }
#undef P2_LOAD
}
__device__ __forceinline__ void dcomb_phase(Frame& F, const Args& a, int l) {
    bf16* PROJ = (bf16*)(a.ws + WS_PROJ); const bf16* O12 = (const bf16*)(a.ws + WS_O12);
    const float* lp = a.in[I_DLAM] + l * 256; const float* go = a.in[I_DON] + l * 128;
    const int gw = blockIdx.x * NWAVES + F.wave, NGW = F.G * NWAVES, lane = F.lane, h = lane >> 3, sub = lane & 7;
    const float lam_init = l == 0 ? 0.2f : (0.8f - 0.6f * 0.7408182206817179f);
    const float s1 = wave_sum(lp[lane] * lp[64 + lane]), s2 = wave_sum(lp[128 + lane] * lp[192 + lane]);
    const float lam = expf(s1) - expf(s2) + lam_init;
#define DC_LOAD(m_, R) do { const bf16* p1_ = O12 + (size_t)(m_) * 2048 + (2 * h) * 128 + sub * 16; R[0] = *(const v4u*)(p1_); R[1] = *(const v4u*)(p1_ + 8); R[2] = *(const v4u*)(p1_ + 128); R[3] = *(const v4u*)(p1_ + 136); } while (0)
    v4u nx[4] = {};
    if (gw < T) DC_LOAD(gw, nx);
    f32x4 gov[4];
#pragma unroll
    for (int c = 0; c < 4; ++c) gov[c] = *(const f32x4*)(go + sub * 16 + c * 4);
    for (int m = gw; m < T; m += NGW) {
        v4u cur[4];
#pragma unroll
        for (int i = 0; i < 4; ++i) cur[i] = nx[i];
        if (m + NGW < T) DC_LOAD(m + NGW, nx);
        float x1[16], x2[16];
        unpack8(cur[0], x1); unpack8(cur[1], x1 + 8); unpack8(cur[2], x2); unpack8(cur[3], x2 + 8);
        float ss = 0.f;
#pragma unroll
        for (int i = 0; i < 16; ++i) { x1[i] = x1[i] - lam * x2[i]; ss += x1[i] * x1[i]; }
        ss += __shfl_xor(ss, 1); ss += __shfl_xor(ss, 2); ss += __shfl_xor(ss, 4);
        const float rstd = (1.0f / sqrtf(ss * (1.f / 128.f) + EPSN)) * (1.0f - lam_init);
#pragma unroll
        for (int c = 0; c < 4; ++c) { const f32x4 gv = gov[c];
#pragma unroll
            for (int i = 0; i < 4; ++i) x1[c * 4 + i] = x1[c * 4 + i] * rstd * gv[i]; }
        bf16* o = PROJ + (size_t)m * NPROJ + PC_DQ + h * 128 + sub * 16;
        *(v4u*)(o) = pack8(x1); *(v4u*)(o + 8) = pack8(x1 + 8);
    }
}
__device__ __forceinline__ void attn_phase(Frame& F, const Args& a, int l) {
    const bf16* PROJ = (const bf16*)(a.ws + WS_PROJ); const bf16* QRAW = (const bf16*)(a.ws + WS_QRAW); const bf16* KVRAW = (const bf16*)(a.ws + WS_KVRAW); const bf16* KN = (const bf16*)(a.ws + WS_KN);
    bf16* O12 = (bf16*)(a.ws + WS_O12); bf16* BB = (bf16*)(a.ws + WS_BB);
    const att::ldsp_t lds = (att::ldsp_t)(F.lds + RING_OFF);
    float gq = 0.f, gk = 0.f, gdq = 0.f, gdk = 0.f;
    { const float* pq = a.in[I_QN] + l * 192; const float* pk = a.in[I_KN] + l * 192; const float* pdq = a.in[I_DQN] + l * 64; const float* pdk = a.in[I_DKN] + l * 64;
      for (int i = F.lane; i < 192; i += 64) { gq = fmaxf(gq, fabsf(pq[i])); gk = fmaxf(gk, fabsf(pk[i])); }
      gdq = fabsf(pdq[F.lane]); gdk = fabsf(pdk[F.lane]);
#pragma unroll
      for (int o = 1; o < 64; o <<= 1) { gq = fmaxf(gq, __shfl_xor(gq, o)); gk = fmaxf(gk, __shfl_xor(gk, o)); gdq = fmaxf(gdq, __shfl_xor(gdq, o)); gdk = fmaxf(gdk, __shfl_xor(gdk, o)); } }
    const float Bmla = 192.f * gq * gk * 0.07216878364870322f * LOG2E, Bdif = 64.f * gdq * gdk * 0.125f * LOG2E;
    const bool fast = __builtin_amdgcn_readfirstlane((Bmla <= 100.f && Bdif <= 100.f) ? 1 : 0) != 0;
#define ATT_MLA_UNITS(FASTV) \
    for (int u = vcid; u < 1024 + (l == 0 ? 16 : 0); u += F.G) { \
        const bool cq = u >= 1024; const int v = cq ? u - 1024 : u; \
        const int b = cq ? (v >> 3) : (v >> 9), h = cq ? (v & 7) : ((v >> 6) & 7), qb = cq ? 0 : (v & 63); \
        const size_t qrow = cq ? (size_t)TL + b * CTXL : (size_t)b * SEQ + qb * 256, crow0 = (size_t)TL + b * CTXL, lrow0 = (size_t)b * SEQ; \
        att::attn_unit<192, FASTV>(QRAW + qrow * 1536 + h * 192, 1536, KN + crow0 * 1536 + h * 192, KN + lrow0 * 1536 + h * 192, 1536, \
                            KVRAW + crow0 * 2048 + h * 256 + 128, KVRAW + lrow0 * 2048 + h * 256 + 128, 2048, (bf16*)PROJ + qrow * NPROJ + PC_RX + h * 128, NPROJ, cq ? 4 : 260, 4, lds); }
#define ATT_DIF_UNITS(FASTV) \
    for (int u = vcid; u < 2048 + (l == 0 ? 32 : 0); u += F.G) {     \
        const bool cq = u >= 2048; const int v = cq ? u - 2048 : u; \
        const int b = cq ? (v >> 4) : (v >> 10), vh = cq ? (v & 15) : ((v >> 6) & 15), qb = cq ? 0 : (v & 63); \
        const size_t qrow = cq ? (size_t)TL + b * CTXL : (size_t)b * SEQ + qb * 256, crow0 = (size_t)TL + b * CTXL, lrow0 = (size_t)b * SEQ; \
        att::attn_unit_pipe<64, FASTV>(PROJ + qrow * NPROJ + PC_DQ + vh * 64, NPROJ, PROJ + crow0 * NPROJ + PC_DK + vh * 64, PROJ + lrow0 * NPROJ + PC_DK + vh * 64, NPROJ, \
                           PROJ + crow0 * NPROJ + PC_DV + (vh >> 1) * 128, PROJ + lrow0 * NPROJ + PC_DV + (vh >> 1) * 128, NPROJ, O12 + qrow * 2048 + vh * 128, 2048, cq ? 4 : 260, 4, lds); }
    const int vcid = (F.G == 256) ? (int)(((blockIdx.x & 7) >> 1) * 64 + (blockIdx.x & 1) * 32 + (blockIdx.x >> 3)) : (int)blockIdx.x;
    if (fast) { ATT_MLA_UNITS(true) ATT_DIF_UNITS(true) } else { ATT_MLA_UNITS(false) ATT_DIF_UNITS(false) }
#undef ATT_MLA_UNITS
#undef ATT_DIF_UNITS
}
constexpr int NPH = 17;
constexpr int NPHASES = 2 * NPH;
#ifndef PH_LIMIT
#define PH_LIMIT NPHASES
#endif
#if MK_FUSED
#define GRID_BAR() xcd_barrier(bar)
#else
#define GRID_BAR() do {} while (0)
#endif
#define IN(k) (lo <= (k) && (k) < hi)
#define SEAM(k) do { if (IN(k) && IN((k) + 1)) GRID_BAR(); } while (0)
template <int l> __device__ __forceinline__ void layer_phases(Frame& F, const Args& args, const XcdBarrier& bar, const int lo, const int hi) {
    unsigned char* ws = args.ws;
    float* MOD = (float*)(ws + WS_MOD);
    float* XC = (float*)(ws + WS_XC);
    bf16* H = (bf16*)(ws + WS_H);
    bf16* PROJ = (bf16*)(ws + WS_PROJ);
    bf16* AFF = PROJ;
    unsigned char* wb = ws + WS_W;
    float* PART = (float*)(ws + WS_QRAW);
    const int cid = (int)blockIdx.x;
        const int pb = l * NPH;
        const float* xl_in = l == 0 ? args.in[I_X] : args.out;
        const float* xc_in = l == 0 ? args.in[I_CTX] : XC;
        const float* MODl = MOD + (size_t)l * 3 * NMOD;
        if (IN(pb + 0)) { conv_phase(F, args, l); if (l == 0) { rope_table_phase(F, args); __syncthreads(); mod_phase(F, args); } }
        SEAM(pb + 0);
        if (IN(pb + 1)) { if constexpr (l == 0) norm_phase(F, args, l, 0, xl_in, xc_in); else norm_phase(F, args, l, 0, xl_in, xc_in, PART, 11, XC); }
        SEAM(pb + 1);
        if (IN(pb + 2)) { pg8::Gemm g{H, (const bf16*)(wb + W_GU), T, 2 * DFF, DM, DM, DM}; pg8::StaticOrder S; S.init(T, 2 * DFF, F.G, cid);
            pg8::EpiSwiglu E{AFF, DFF}; pg8::gemm_phase<pg8::EpiSwiglu, pg8::StaticOrder, true, true>(F.lds + RING_OFF, g, S, E); }
        SEAM(pb + 2);
        if (IN(pb + 3)) { pg8::Gemm g{AFF, (const bf16*)(wb + W_D), T, DM, DFF, DFF, DFF}; pg8::SplitTailOrder<DFF, 11> S; S.init(TL, DM, 2, F.G, cid);
            pg8::EpiResid E{xl_in, xc_in, args.out, XC, MODl + 2 * DM, PART, 0.5f}; pg8::gemm_phase<pg8::EpiResid, pg8::SplitTailOrder<DFF, 11>, true, true>(F.lds + RING_OFF, g, S, E); }
        SEAM(pb + 3);
        if (IN(pb + 4)) norm_phase(F, args, l, 1, args.out, xc_in, PART, 11, XC);
        SEAM(pb + 4);
        if (IN(pb + 5)) { pg8::Gemm g{H, (const bf16*)(wb + W_IN), T, NPROJ, DM, DM, DM}; pg8::StaticOrder S; S.init(T, NPROJ, F.G, cid);
            pg8::EpiAct<1> E{PROJ, NPROJ}; pg8::gemm_phase<pg8::EpiAct<1>, pg8::StaticOrder, true, true>(F.lds + RING_OFF, g, S, E); }
        SEAM(pb + 5);
        if (IN(pb + 6)) { prep1_phase(F, args, l); lru_phase<false>(F, args, l); }
        SEAM(pb + 6);
        if (IN(pb + 7)) {
            { pg8::Gemm g{PROJ + PC_QC, (const bf16*)(wb + W_UQ), T, 1536, 512, NPROJ, 512}; pg8::StaticOrder S; S.init(T, 1536, F.G, cid);
              pg8::EpiAct<0> E{(bf16*)(ws + WS_QRAW), 1536}; pg8::gemm_phase<pg8::EpiAct<0>, pg8::StaticOrder, true, true>(F.lds + RING_OFF, g, S, E); }
            { pg8::Gemm g{PROJ + PC_KVC, (const bf16*)(wb + W_UKV), T, 2048, 256, NPROJ, 256}; pg8::StaticOrder S; S.init(T, 2048, F.G, cid);
              pg8::EpiAct<0> E{(bf16*)(ws + WS_KVRAW), 2048}; pg8::gemm_phase<pg8::EpiAct<0>, pg8::StaticOrder, true, true>(F.lds + RING_OFF, g, S, E); }
            lru_phase<true>(F, args, l);
        }
        SEAM(pb + 7);
        if (IN(pb + 8)) prep2_phase(F, args, l);
        SEAM(pb + 8);
        if (IN(pb + 9)) attn_phase(F, args, l);
        SEAM(pb + 9);
        constexpr int MT = (l == 1) ? TL : T;
        if (IN(pb + 10) || IN(pb + 11)) { if (IN(pb + 10)) dcomb_phase(F, args, l); }
        if (IN(pb + 11)) { pg8::Gemm g{H, (const bf16*)(wb + W_GT), MT, NPROJ, DM, DM, DM}; pg8::StaticOrder S; S.init(MT, NPROJ, F.G, cid);
            pg8::EpiAct<2> E{(bf16*)(ws + WS_GATES), NPROJ}; pg8::gemm_phase<pg8::EpiAct<2>, pg8::StaticOrder, true, true>(F.lds + RING_OFF, g, S, E); }
        SEAM(pb + 11);
        if (IN(pb + 12)) {
            pg8::Gemm g{PROJ, (const bf16*)(wb + W_BP), MT, DM, 1024, NPROJ, 1024}; using MO = pg8::MergeOrder<(unsigned)PC_RG * 2u, (unsigned)PC_RX * 2u, (unsigned)PC_DQ * 2u, (unsigned)W_BP_SZ>; MO S; S.init(MT, DM, F.G, cid);
            pg8::EpiMergeRT E{H, (const bf16*)(ws + WS_GATES)}; pg8::gemm_phase<pg8::EpiMergeRT, MO, true, true>(F.lds + RING_OFF, g, S, E); }
        SEAM(pb + 12);
        if (IN(pb + 13)) { pg8::Gemm g{H, (const bf16*)(wb + W_OUT), MT, DM, DM, DM, DM}; pg8::StaticOrder S; S.init(MT, DM, F.G, cid);
            pg8::EpiResid E{args.out, XC, args.out, XC, MODl + 5 * DM, nullptr, 1.0f}; pg8::gemm_phase<pg8::EpiResid, pg8::StaticOrder, true, true>(F.lds + RING_OFF, g, S, E); }
        SEAM(pb + 13);
        if (IN(pb + 14)) norm_phase(F, args, l, 2, args.out, XC);
        SEAM(pb + 14);
        if (IN(pb + 15)) { pg8::Gemm g{H, (const bf16*)(wb + W_GU + W_GU_SZ), MT, 2 * DFF, DM, DM, DM}; pg8::StaticOrder S; S.init(MT, 2 * DFF, F.G, cid);
            pg8::EpiSwiglu E{AFF, DFF}; pg8::gemm_phase<pg8::EpiSwiglu, pg8::StaticOrder, true, true>(F.lds + RING_OFF, g, S, E); }
        SEAM(pb + 15);
        if (IN(pb + 16)) { pg8::Gemm g{AFF, (const bf16*)(wb + W_D + W_D_SZ), MT, DM, DFF, DFF, DFF}; pg8::SplitTailOrder<DFF, 11> S; S.init(TL, DM, l == 1 ? 0 : 2, F.G, cid);
            pg8::EpiResid E{args.out, XC, args.out, XC, MODl + 8 * DM, PART, 0.5f}; pg8::gemm_phase<pg8::EpiResid, pg8::SplitTailOrder<DFF, 11>, true, true>(F.lds + RING_OFF, g, S, E); }
        SEAM(pb + 16);

    }
#undef IN
#undef SEAM
__global__ void __launch_bounds__(NWAVES * 64, 2) fwd(Args args) {
    extern __shared__ __attribute__((aligned(16))) unsigned char lds[];
    Frame F;
    F.lds = (LAS unsigned char*)lds;
    F.MISC = (volatile LAS unsigned*)(F.lds + MISC_OFF);
    F.tid = threadIdx.x; F.lane = F.tid & 63; F.wave = __builtin_amdgcn_readfirstlane(F.tid >> 6);
    F.G = gridDim.x;
    F.ctl = (gu32*)(args.ws + WS_CTL);
    for (int u = F.tid; u < (LDS_BYTES - LDSCTL_OFF) / 4; u += NWAVES * 64) ((LAS unsigned*)(F.lds + LDSCTL_OFF))[u] = 0u;
    __syncthreads();
#if MK_FUSED
    XcdBarrier bar = xcd_barrier_post((unsigned*)(F.ctl + CW_BAR), F.MISC + 8);
#else
    XcdBarrier bar; bar.bar = nullptr; bar.x = 0; bar.st = nullptr;
#endif
    layer_phases<0>(F, args, bar, args.ph_lo, args.ph_hi);
    layer_phases<1>(F, args, bar, args.ph_lo, args.ph_hi);
}

extern "C" void kernel_launch(void* const* d_in, const int* in_sizes, int n_in, void* d_out, int out_size, void* d_ws, size_t ws_size, hipStream_t stream) {
    static int grid = 0;
    if (grid == 0) {
        if (n_in != N_INPUTS || in_sizes[0] != TL * DM || out_size != TL * DM || ws_size < WS_END) { fprintf(stderr, "kernel_launch: shape/workspace mismatch (n_in %d, ws %zu, need %zu)\n", n_in, ws_size, (size_t)WS_END); grid = -1; return; }
        int dev = 0, cus = 0, per_cu = 0;
        if (hipGetDevice(&dev) != hipSuccess || hipDeviceGetAttribute(&cus, hipDeviceAttributeMultiprocessorCount, dev) != hipSuccess) { grid = -1; return; }
        if (hipFuncSetAttribute((const void*)fwd, hipFuncAttributeMaxDynamicSharedMemorySize, LDS_BYTES) != hipSuccess) { fprintf(stderr, "kernel_launch: hipFuncSetAttribute failed\n"); grid = -1; return; }
        if (hipOccupancyMaxActiveBlocksPerMultiprocessor(&per_cu, (const void*)fwd, NWAVES * 64, LDS_BYTES) != hipSuccess || per_cu < 1) fprintf(stderr, "kernel_launch: occupancy query reports %d\n", per_cu);
        (void)hipGetLastError();
        grid = cus;
    }
    if (grid < 0) return;
    if (hipMemsetAsync((char*)d_ws + WS_CTL, 0, CTL_ZERO_BYTES, stream) != hipSuccess) return;
    Args a{};
    for (int i = 0; i < N_INPUTS; ++i) a.in[i] = (const float*)d_in[i];
    a.out = (float*)d_out; a.ws = (unsigned char*)d_ws;
#if MK_FUSED
    a.ph_lo = 0; a.ph_hi = PH_LIMIT;
    hipLaunchKernelGGL(fwd, dim3(grid), dim3(NWAVES * 64), LDS_BYTES, stream, a);
#else
    for (int ph = 0; ph < PH_LIMIT; ++ph) { a.ph_lo = ph; a.ph_hi = ph + 1; hipLaunchKernelGGL(fwd, dim3(grid), dim3(NWAVES * 64), LDS_BYTES, stream, a); }
#endif
    const hipError_t le = hipPeekAtLastError();
    if (le != hipSuccess) fprintf(stderr, "kernel_launch: launch failed: %s\n", hipGetErrorName(le));
}
```

```cpp
#include <hip/hip_runtime.h>
#include <cstdio>
#include <cstdint>
#ifndef MK_FUSED
#define MK_FUSED 1
#endif
#define PH_LIMIT 34
namespace pg8 {
#define PG8_LAS __attribute__((address_space(3)))
typedef unsigned short bf16_t;
typedef short bf16x8 __attribute__((ext_vector_type(8)));
typedef float f32x4 __attribute__((ext_vector_type(4)));
typedef unsigned u32x4 __attribute__((ext_vector_type(4)));
constexpr int BM = 256, BK = 64, HALF = 128, HTB = HALF * BK * 2  , STAGE_BYTES = 8 * HTB, NXCD = 8, WGM = 8;

__host__ __device__ __forceinline__ int lds_byte(int r, int c) { const int st = (r >> 4) * 2 + (c >> 5), rr = r & 15, cc = c & 31, ob = rr * 64 + cc * 2; return st * 1024 + (ob ^ (((ob >> 9) & 1) << 5)); }
__host__ __device__ __forceinline__ void stage_rc(int b, int& R, int& C) { const int st = b / 1024, sb = b % 1024, swz = sb ^ (((sb >> 9) & 1) << 5); R = (st >> 1) * 16 + swz / 64; C = (st & 1) * 32 + (swz % 64) / 2; }
__host__ __device__ __forceinline__ int perm32(int rho) { const int n = rho >> 4, i = rho & 15; return 8 * (i >> 2) + 4 * n + (i & 3); }

struct Unit { int pm, pn, ks; };
struct Gemm { const bf16_t* A; const bf16_t* Bt; int M, N, K, lda, ldb; };

struct StaticOrder {
    static constexpr int KSL = 0;
    int nM, nN, nwg, G, c;
    __host__ __device__ void init(int M, int N, int G_, int c_) { nM = M / BM; nN = N / BM; nwg = nM * nN; G = G_; c = c_; }
    __host__ __device__ bool next(int i, Unit& u) const {
        const long L = (long)i * G + c; if (L >= nwg) return false;
        int wgid = (int)L; { const int q = nwg / NXCD, r = nwg % NXCD, xcd = wgid % NXCD, off = wgid / NXCD; wgid = (xcd < r ? xcd * (q + 1) : r * (q + 1) + (xcd - r) * q) + off; }
        const int nig = WGM * nN, gid = wgid / nig, fm = gid * WGM, gsz = (nM - fm) < WGM ? (nM - fm) : WGM;
        u.pm = fm + ((wgid % nig) % gsz); u.pn = (wgid % nig) / gsz; u.ks = 0; return true;
    }
    __device__ __forceinline__ size_t a_off(const Unit&) const { return 0; }
    __device__ __forceinline__ size_t b_off(const Unit&) const { return 0; }
    __device__ __forceinline__ void a_ready(const Unit&) const {}
    __device__ __forceinline__ void done(const Unit&) const {}
};

template <int K_, int S_> struct SplitTailOrder {
    static constexpr int KSL = K_ / S_;
    static_assert(K_ % S_ == 0 && KSL % 128 == 0 && KSL >= 256, "slice length: a multiple of 128, >= 256");
    StaticOrder base; int nN, c, G, nreg, nsl;
    __host__ __device__ void init(int Mlat, int N, int nctx, int G_, int c_) { base.init(Mlat, N, G_, c_); nN = N / BM; c = c_; G = G_; nreg = (base.nwg - c_ + G_ - 1) / G_; if (nreg < 0) nreg = 0; nsl = nctx * nN * S_; }
    __host__ __device__ bool next(int i, Unit& u) const {
        if (i < nreg) return base.next(i, u);
        const int s = (i - nreg) * G + c; if (s >= nsl) return false;
        const int tile = s / S_; u.pm = base.nM + tile / nN; u.pn = tile % nN; u.ks = 1 + s % S_; return true;
    }
    __device__ __forceinline__ size_t a_off(const Unit&) const { return 0; }
    __device__ __forceinline__ size_t b_off(const Unit&) const { return 0; }
    __device__ __forceinline__ void a_ready(const Unit&) const {}
    __device__ __forceinline__ void done(const Unit&) const {}
};

template <unsigned A0, unsigned A1, unsigned A2, unsigned BS>
struct MergeOrder {
    static constexpr int KSL = 0;
    StaticOrder base;
    __host__ __device__ void init(int M, int N, int G_, int c_) { base.init(M, N, G_, c_); }
    __host__ __device__ bool next(int i, Unit& u) const { const int q = i / 3; if (!base.next(q, u)) return false; u.ks = i - 3 * q; return true; }
    __device__ __forceinline__ size_t a_off(const Unit& u) const { return u.ks == 0 ? (size_t)A0 : (u.ks == 1 ? (size_t)A1 : (size_t)A2); }
    __device__ __forceinline__ size_t b_off(const Unit& u) const { return (size_t)u.ks * BS; }
    __device__ __forceinline__ void a_ready(const Unit&) const {}
    __device__ __forceinline__ void done(const Unit&) const {}
};

typedef float f32x2_c __attribute__((ext_vector_type(2))); typedef __bf16 bf16x2_c __attribute__((ext_vector_type(2)));
__device__ __forceinline__ unsigned cvt_pk_bf16(float lo, float hi) { f32x2_c v = {lo, hi}; bf16x2_c b = __builtin_convertvector(v, bf16x2_c); return __builtin_bit_cast(unsigned, b); }
typedef float f32x2 __attribute__((ext_vector_type(2)));
__device__ __forceinline__ f32x2 gelu_pk(f32x2 v) {
    const f32x2 av = __builtin_elementwise_abs(v), d = av * 0.2316418882f + 1.0f;
    f32x2 t; t.x = __builtin_amdgcn_rcpf(d.x); t.y = __builtin_amdgcn_rcpf(d.y);
    f32x2 q = t * 0.5307027145f + (-0.7265760135f); q = q * t + 0.7107068705f; q = q * t + (-0.142248368f); q = q * t + 0.127414796f; q = q * t;
    const f32x2 s = (v * v) * (-0.72134752044f);
    f32x2 e; e.x = __builtin_amdgcn_exp2f(s.x); e.y = __builtin_amdgcn_exp2f(s.y);
    const f32x2 m = v * (q * e), r = v - m;
    f32x2 o; o.x = v.x < 0.f ? m.x : r.x; o.y = v.y < 0.f ? m.y : r.y; return o;
}

__device__ __forceinline__ float sigmoid_f(float x) { return __builtin_amdgcn_rcpf(1.f + __builtin_amdgcn_exp2f(-1.4426950408889634f * x)); }
__device__ __forceinline__ float silu_f(float x) { return x * sigmoid_f(x); }
__device__ __forceinline__ float gelu_tanh_f(float x) { const float z = 0.7978845608028654f * (x + 0.044715f * x * x * x); return x * sigmoid_f(2.f * z); }
__device__ __forceinline__ float bf_lo(unsigned w) { return __uint_as_float(w << 16); }
__device__ __forceinline__ float bf_hi(unsigned w) { return __uint_as_float(w & 0xffff0000u); }

struct EpiSwiglu {
    static constexpr bool PERM = true, AFTER_DRAIN = false;
    bf16_t* O; int ldc;
    __device__ __forceinline__ void operator()(const f32x4 (&acc)[2][2][4][2], const Unit& u, int wr, int wc, int fr, int fq) const {
        const int row0 = u.pm * BM + wr * 64 + fr, col0 = u.pn * HALF + wc * 32 + 8 * fq;
#pragma unroll
        for (int ai = 0; ai < 2; ++ai)
#pragma unroll
            for (int m = 0; m < 4; ++m) {
                bf16_t* rowp = O + (size_t)(row0 + ai * HALF + m * 16) * ldc + col0;
                const f32x4 g0 = acc[ai][0][m][0], g1 = acc[ai][0][m][1], u0 = acc[ai][1][m][0], u1 = acc[ai][1][m][1];
                u32x4 w;
                w.x = cvt_pk_bf16(silu_f(g0[0]) * u0[0], silu_f(g0[1]) * u0[1]); w.y = cvt_pk_bf16(silu_f(g0[2]) * u0[2], silu_f(g0[3]) * u0[3]);
                w.z = cvt_pk_bf16(silu_f(g1[0]) * u1[0], silu_f(g1[1]) * u1[1]); w.w = cvt_pk_bf16(silu_f(g1[2]) * u1[2], silu_f(g1[3]) * u1[3]);
                *(u32x4*)rowp = w;
            }
    }
};
struct EpiResid {
    static constexpr bool PERM = false, AFTER_DRAIN = false;
    const float* base_lat; const float* base_ctx; float* out_lat; float* out_ctx; const float* gate; float* part; float gs;
    __device__ __forceinline__ void operator()(const f32x4 (&acc)[2][2][4][2], const Unit& u, int wr, int wc, int fr, int fq) const {
        const bool isl = u.pm < 128;
        const float* base = isl ? base_lat + (size_t)u.pm * BM * 2048 : base_ctx + (size_t)(u.pm - 128) * BM * 2048;
        float* out = isl ? out_lat + (size_t)u.pm * BM * 2048 : out_ctx + (size_t)(u.pm - 128) * BM * 2048;
        const int mrow = u.pm < 64 ? 0 : (u.pm < 128 ? 1 : 2);
        const float* gp = gate + (size_t)mrow * 18432;
        const int col0 = u.pn * BM + wc * 32 + 4 * fq;
        f32x4 gv[2][2];
#pragma unroll
        for (int bj = 0; bj < 2; ++bj)
#pragma unroll
            for (int n = 0; n < 2; ++n) gv[bj][n] = *(const f32x4*)(gp + col0 + bj * HALF + n * 16) * gs;
        if (u.ks != 0) {
            float* pp = part + (size_t)(u.ks - 1) * (512 * 2048) + (size_t)(u.pm - 128) * BM * 2048;
#pragma unroll
            for (int bj = 0; bj < 2; ++bj)
#pragma unroll
                for (int n = 0; n < 2; ++n)
#pragma unroll
                    for (int ai = 0; ai < 2; ++ai)
#pragma unroll
                        for (int m = 0; m < 4; ++m) {
                            const size_t off = (size_t)(ai * HALF + wr * 64 + m * 16 + fr) * 2048 + col0 + bj * HALF + n * 16;
                            *(f32x4*)(pp + off) = gv[bj][n] * acc[ai][bj][m][n]; }
        } else {
#pragma unroll
            for (int bj = 0; bj < 2; ++bj)
#pragma unroll
              for (int n = 0; n < 2; ++n) {
                f32x4 b[2][4];
#pragma unroll
                for (int ai = 0; ai < 2; ++ai)
#pragma unroll
                    for (int m = 0; m < 4; ++m) b[ai][m] = *(const f32x4*)(base + (size_t)(ai * HALF + wr * 64 + m * 16 + fr) * 2048 + col0 + bj * HALF + n * 16);
#pragma unroll
                for (int ai = 0; ai < 2; ++ai)
#pragma unroll
                    for (int m = 0; m < 4; ++m)
                        *(f32x4*)(out + (size_t)(ai * HALF + wr * 64 + m * 16 + fr) * 2048 + col0 + bj * HALF + n * 16) = b[ai][m] + gv[bj][n] * acc[ai][bj][m][n];
              }
        }
    }
};
template <int ACT> struct EpiAct {
    static constexpr bool PERM = true, AFTER_DRAIN = false;
    bf16_t* O; int ldc;
    __device__ __forceinline__ void operator()(const f32x4 (&acc)[2][2][4][2], const Unit& u, int wr, int wc, int fr, int fq) const {
        const int row0 = u.pm * BM + wr * 64 + fr, col0 = u.pn * BM + wc * 32 + 8 * fq;
        const bool dog = (ACT == 1) && (u.pn >= 4 && u.pn < 8);
#pragma unroll
        for (int ai = 0; ai < 2; ++ai)
#pragma unroll
            for (int m = 0; m < 4; ++m) {
                bf16_t* rowp = O + (size_t)(row0 + ai * HALF + m * 16) * ldc + col0;
#pragma unroll
                for (int bj = 0; bj < 2; ++bj) {
                    f32x4 v0 = acc[ai][bj][m][0], v1 = acc[ai][bj][m][1];
                    if (ACT == 1) { if (dog) {
#pragma unroll
                        for (int j = 0; j < 4; ++j) { v0[j] = gelu_tanh_f(v0[j]); v1[j] = gelu_tanh_f(v1[j]); } } }
                    if (ACT == 2) {
#pragma unroll
                        for (int j = 0; j < 4; ++j) { v0[j] = sigmoid_f(v0[j]); v1[j] = sigmoid_f(v1[j]); } }
                    u32x4 w; w.x = cvt_pk_bf16(v0[0], v0[1]); w.y = cvt_pk_bf16(v0[2], v0[3]); w.z = cvt_pk_bf16(v1[0], v1[1]); w.w = cvt_pk_bf16(v1[2], v1[3]);
                    *(u32x4*)(rowp + bj * HALF) = w;
                }
            }
    }
};
struct EpiMergeRT {
    static constexpr bool PERM = true, AFTER_DRAIN = false;
    bf16_t* R; const bf16_t* gates;
    __device__ __forceinline__ void operator()(const f32x4 (&acc)[2][2][4][2], const Unit& u, int wr, int wc, int fr, int fq) const {
        const int row0 = u.pm * BM + wr * 64 + fr, col0 = u.pn * BM + wc * 32 + 8 * fq; const int J = u.ks;
#pragma unroll
        for (int ai = 0; ai < 2; ++ai)
#pragma unroll
          for (int mh = 0; mh < 2; ++mh) {
            u32x4 gwv[4][2], rov[4][2];
#pragma unroll
            for (int m = 2 * mh; m < 2 * mh + 2; ++m)
#pragma unroll
                for (int bj = 0; bj < 2; ++bj) {
                    const size_t row = (size_t)(row0 + ai * HALF + m * 16);
                    gwv[m][bj] = *(const u32x4*)(gates + row * 6144 + J * 2048 + col0 + bj * HALF);
                    rov[m][bj] = (u32x4){0u, 0u, 0u, 0u}; if (J > 0) rov[m][bj] = *(const u32x4*)(R + row * 2048 + col0 + bj * HALF);
                }
#pragma unroll
            for (int m = 2 * mh; m < 2 * mh + 2; ++m)
#pragma unroll
                for (int bj = 0; bj < 2; ++bj) {
                    const size_t row = (size_t)(row0 + ai * HALF + m * 16);
                    const u32x4 gw = gwv[m][bj], ro = rov[m][bj];
                    const f32x4 v0 = acc[ai][bj][m][0], v1 = acc[ai][bj][m][1];
                    u32x4 w;
                    w.x = cvt_pk_bf16(bf_lo(ro.x) + bf_lo(gw.x) * v0[0], bf_hi(ro.x) + bf_hi(gw.x) * v0[1]);
                    w.y = cvt_pk_bf16(bf_lo(ro.y) + bf_lo(gw.y) * v0[2], bf_hi(ro.y) + bf_hi(gw.y) * v0[3]);
                    w.z = cvt_pk_bf16(bf_lo(ro.z) + bf_lo(gw.z) * v1[0], bf_hi(ro.z) + bf_hi(gw.z) * v1[1]);
                    w.w = cvt_pk_bf16(bf_lo(ro.w) + bf_lo(gw.w) * v1[2], bf_hi(ro.w) + bf_hi(gw.w) * v1[3]);
                    *(u32x4*)(R + row * 2048 + col0 + bj * HALF) = w;
                }
        }
    }
};
template <int J> struct EpiMerge {
    static constexpr bool PERM = true, AFTER_DRAIN = false;
    bf16_t* R; const bf16_t* gates;
    __device__ __forceinline__ void operator()(const f32x4 (&acc)[2][2][4][2], const Unit& u, int wr, int wc, int fr, int fq) const {
        const int row0 = u.pm * BM + wr * 64 + fr, col0 = u.pn * BM + wc * 32 + 8 * fq;
#pragma unroll
        for (int ai = 0; ai < 2; ++ai)
#pragma unroll
            for (int m = 0; m < 4; ++m) {
                const size_t row = (size_t)(row0 + ai * HALF + m * 16);
#pragma unroll
                for (int bj = 0; bj < 2; ++bj) {
                    const u32x4 gw = *(const u32x4*)(gates + row * 6144 + J * 2048 + col0 + bj * HALF);
                    bf16_t* rp = R + row * 2048 + col0 + bj * HALF;
                    u32x4 ro = (u32x4){0u, 0u, 0u, 0u}; if (J > 0) ro = *(const u32x4*)rp;
                    const f32x4 v0 = acc[ai][bj][m][0], v1 = acc[ai][bj][m][1];
                    u32x4 w;
                    w.x = cvt_pk_bf16(bf_lo(ro.x) + bf_lo(gw.x) * v0[0], bf_hi(ro.x) + bf_hi(gw.x) * v0[1]);
                    w.y = cvt_pk_bf16(bf_lo(ro.y) + bf_lo(gw.y) * v0[2], bf_hi(ro.y) + bf_hi(gw.y) * v0[3]);
                    w.z = cvt_pk_bf16(bf_lo(ro.z) + bf_lo(gw.z) * v1[0], bf_hi(ro.z) + bf_hi(gw.z) * v1[1]);
                    w.w = cvt_pk_bf16(bf_lo(ro.w) + bf_lo(gw.w) * v1[2], bf_hi(ro.w) + bf_hi(gw.w) * v1[3]);
                    *(u32x4*)rp = w;
                }
            }
    }
};
template <class Epi, class Sched, bool ALIGN_EPI = false, bool SP2 = false>
__device__ __forceinline__ void gemm_phase(PG8_LAS unsigned char* lds, const Gemm g, const Sched& S, const Epi& E) {
    const int tid = threadIdx.x, wid = __builtin_amdgcn_readfirstlane(tid >> 6), lane = tid & 63, wr = wid >> 2, wc = wid & 3, fr = lane & 15, fq = lane >> 4;
    const int K = g.K, nt = K / BK;
    unsigned voffA[2], voffB[2];
#pragma unroll
    for (int i = 0; i < 2; ++i) { int R, C; stage_rc(tid * 16 + i * 8192, R, C); const int Rb = Epi::PERM ? ((R & ~31) + perm32(R & 31)) : R;
        voffA[i] = (unsigned)(R * g.lda + C) * 2u; voffB[i] = (unsigned)(Rb * g.ldb + C) * 2u; }
    const size_t kstep = (size_t)(BK * 2);
    const size_t hstepA = (size_t)HALF * g.lda * 2, hstepB = (size_t)HALF * g.ldb * 2;
    const size_t tstepA = 2 * hstepA, tstepB = 2 * hstepB;
    const unsigned ldsw = (unsigned)wid * 1024u;
    const int aoff = lds_byte(wr * 64 + fr, fq * 8), boff = lds_byte(wc * 32 + fr, fq * 8);
#define PG8_SA(b, h) (((b) * 2 + (h)) * HTB)
#define PG8_SB(b, h) ((4 + (b) * 2 + (h)) * HTB)
#define PG8_STAGE(bufoff, gbase, voff) do { _Pragma("unroll") for (int _i = 0; _i < 2; ++_i) \
        __builtin_amdgcn_global_load_lds((const unsigned*)((const char*)(gbase) + (voff)[_i]), (PG8_LAS unsigned*)(lds + (bufoff) + ldsw + _i * 8192), 16, 0, 0); } while (0)
#define PG8_LDA(dst, b, h) do { _Pragma("unroll") for (int m = 0; m < 4; ++m) _Pragma("unroll") for (int k = 0; k < 2; ++k) dst[m][k] = *(const PG8_LAS bf16x8*)(lds + PG8_SA(b, h) + aoff + m * 2048 + k * 1024); } while (0)
#define PG8_LDB(dst, b, h) do { _Pragma("unroll") for (int n = 0; n < 2; ++n) _Pragma("unroll") for (int k = 0; k < 2; ++k) dst[n][k] = *(const PG8_LAS bf16x8*)(lds + PG8_SB(b, h) + boff + n * 2048 + k * 1024); } while (0)
#define PG8_MMA(ai, bj, At, Bt) do { __builtin_amdgcn_s_setprio(1); _Pragma("unroll") for (int m = 0; m < 4; ++m) _Pragma("unroll") for (int n = 0; n < 2; ++n) _Pragma("unroll") for (int k = 0; k < 2; ++k) \
        acc[ai][bj][m][n] = __builtin_amdgcn_mfma_f32_16x16x32_bf16(Bt[n][k], At[m][k], acc[ai][bj][m][n], 0, 0, 0); __builtin_amdgcn_s_setprio(0); } while (0)
#define PG8_WAIT_V(n) asm volatile("s_waitcnt vmcnt(" #n ")" ::: "memory")
#define PG8_WAIT_L(n) asm volatile("s_waitcnt lgkmcnt(" #n ")" ::: "memory")
#define PG8_BAR __builtin_amdgcn_s_barrier()
#define PG8_SCHED __builtin_amdgcn_sched_barrier(0)
    Unit cur, nxt; int ui = 0;
    if (!S.next(0, cur)) return;
    f32x4 acc[2][2][4][2];
#pragma unroll
    for (int a = 0; a < 2; ++a)
#pragma unroll
        for (int b = 0; b < 2; ++b)
#pragma unroll
            for (int m = 0; m < 4; ++m)
#pragma unroll
                for (int n = 0; n < 2; ++n) acc[a][b][m][n] = (f32x4){0.f, 0.f, 0.f, 0.f};
    bf16x8 At[4][2], B0[2][2], B1[2][2];
    const char* cA = (const char*)g.A + (size_t)cur.pm * tstepA + (Sched::KSL != 0 && cur.ks ? (cur.ks - 1) * (Sched::KSL * 2) : 0) + S.a_off(cur); const char* cB = (const char*)g.Bt + (size_t)cur.pn * tstepB + (Sched::KSL != 0 && cur.ks ? (cur.ks - 1) * (Sched::KSL * 2) : 0) + S.b_off(cur);
    S.a_ready(cur);
    if constexpr (SP2) {
        PG8_STAGE(PG8_SB(0, 0), cB, voffB); PG8_STAGE(PG8_SB(0, 1), cB + hstepB, voffB); PG8_STAGE(PG8_SA(0, 0), cA, voffA); PG8_STAGE(PG8_SA(0, 1), cA + hstepA, voffA);
        if (wr == 1) PG8_BAR;
        PG8_WAIT_V(2); PG8_BAR;
        PG8_STAGE(PG8_SB(1, 0), cB + kstep, voffB); PG8_STAGE(PG8_SA(1, 0), cA + kstep, voffA); PG8_STAGE(PG8_SB(1, 1), cB + hstepB + kstep, voffB);
        PG8_WAIT_V(6); PG8_BAR;
    } else {
        PG8_STAGE(PG8_SB(0, 0), cB, voffB); PG8_STAGE(PG8_SA(0, 0), cA, voffA); PG8_STAGE(PG8_SB(0, 1), cB + hstepB, voffB); PG8_STAGE(PG8_SA(0, 1), cA + hstepA, voffA);
        if (wr == 1) PG8_BAR;
        PG8_WAIT_V(4); PG8_BAR;
        PG8_STAGE(PG8_SB(1, 0), cB + kstep, voffB); PG8_STAGE(PG8_SA(1, 0), cA + kstep, voffA); PG8_STAGE(PG8_SB(1, 1), cB + hstepB + kstep, voffB);
        PG8_WAIT_V(6); PG8_BAR;
    }
    for (;;) {
        const bool has_next = S.next(ui + 1, nxt);
        const char* nA = has_next ? (const char*)g.A + (size_t)nxt.pm * tstepA + (Sched::KSL != 0 && nxt.ks ? (nxt.ks - 1) * (Sched::KSL * 2) : 0) + S.a_off(nxt) : cA; const char* nB = has_next ? (const char*)g.Bt + (size_t)nxt.pn * tstepB + (Sched::KSL != 0 && nxt.ks ? (nxt.ks - 1) * (Sched::KSL * 2) : 0) + S.b_off(nxt) : cB;
        const int cnt = (Sched::KSL != 0 && cur.ks) ? Sched::KSL / BK : nt;
        for (int t = 0; t < cnt; t += 2) {
            const bool last = (t == cnt - 2);
            const char* a1 = cA + (size_t)(t + 1) * kstep;
            const char* a2 = last ? nA : cA + (size_t)(t + 2) * kstep; const char* b2 = last ? nB : cB + (size_t)(t + 2) * kstep;
            const char* a3 = a2 + kstep; const char* b3 = b2 + kstep;
            if (last && has_next) S.a_ready(nxt);
            if constexpr (SP2) {
            PG8_LDB(B0, 0, 0); PG8_LDB(B1, 0, 1); PG8_SCHED; PG8_LDA(At, 0, 0); PG8_STAGE(PG8_SA(1, 1), a1 + hstepA, voffA);
            PG8_WAIT_V(8); PG8_WAIT_L(0); PG8_BAR; PG8_MMA(0, 0, At, B0); PG8_MMA(0, 1, At, B1); PG8_BAR; PG8_SCHED;
            PG8_LDA(At, 0, 1); PG8_STAGE(PG8_SB(0, 0), b2, voffB); PG8_STAGE(PG8_SB(0, 1), b2 + hstepB, voffB); PG8_STAGE(PG8_SA(0, 0), a2, voffA);
            PG8_WAIT_V(8); PG8_WAIT_L(0); PG8_BAR; PG8_MMA(1, 0, At, B0); PG8_MMA(1, 1, At, B1); PG8_BAR; PG8_SCHED;
            PG8_LDB(B0, 1, 0); PG8_LDB(B1, 1, 1); PG8_SCHED; PG8_LDA(At, 1, 0); PG8_STAGE(PG8_SA(0, 1), a2 + hstepA, voffA);
            PG8_WAIT_V(8); PG8_WAIT_L(0); PG8_BAR; PG8_MMA(0, 0, At, B0); PG8_MMA(0, 1, At, B1); PG8_BAR; PG8_SCHED;
            PG8_LDA(At, 1, 1); PG8_STAGE(PG8_SB(1, 0), b3, voffB); PG8_STAGE(PG8_SB(1, 1), b3 + hstepB, voffB); PG8_STAGE(PG8_SA(1, 0), a3, voffA);
            PG8_WAIT_V(8); PG8_WAIT_L(0); PG8_BAR; PG8_MMA(1, 0, At, B0); PG8_MMA(1, 1, At, B1); PG8_BAR; PG8_SCHED;
            } else {
            PG8_LDB(B0, 0, 0); PG8_SCHED; PG8_LDA(At, 0, 0); PG8_STAGE(PG8_SA(1, 1), a1 + hstepA, voffA);
            PG8_WAIT_L(8); PG8_BAR; PG8_WAIT_L(0); PG8_MMA(0, 0, At, B0); PG8_BAR; PG8_SCHED;
            PG8_LDB(B1, 0, 1); PG8_STAGE(PG8_SB(0, 0), b2, voffB);
            PG8_BAR; PG8_WAIT_L(0); PG8_MMA(0, 1, At, B1); PG8_BAR;
            PG8_LDA(At, 0, 1); PG8_STAGE(PG8_SA(0, 0), a2, voffA);
            PG8_BAR; PG8_WAIT_L(0); PG8_MMA(1, 0, At, B0); PG8_BAR; PG8_SCHED;
            PG8_STAGE(PG8_SB(0, 1), b2 + hstepB, voffB);
            PG8_WAIT_V(6); PG8_BAR; PG8_MMA(1, 1, At, B1); PG8_BAR;
            PG8_LDB(B0, 1, 0); PG8_SCHED; PG8_LDA(At, 1, 0); PG8_STAGE(PG8_SA(0, 1), a2 + hstepA, voffA);
            PG8_WAIT_L(8); PG8_BAR; PG8_WAIT_L(0); PG8_MMA(0, 0, At, B0); PG8_BAR; PG8_SCHED;
            PG8_LDB(B1, 1, 1); PG8_STAGE(PG8_SB(1, 0), b3, voffB);
            PG8_BAR; PG8_WAIT_L(0); PG8_MMA(0, 1, At, B1); PG8_BAR;
            PG8_LDA(At, 1, 1); PG8_STAGE(PG8_SA(1, 0), a3, voffA);
            PG8_BAR; PG8_WAIT_L(0); PG8_MMA(1, 0, At, B0); PG8_BAR; PG8_SCHED;
            PG8_STAGE(PG8_SB(1, 1), b3 + hstepB, voffB);
            PG8_WAIT_V(6); PG8_BAR; PG8_MMA(1, 1, At, B1); PG8_BAR;
            }
        }
        if constexpr (ALIGN_EPI) { if (wr == 0) PG8_BAR; }
        if constexpr (!Epi::AFTER_DRAIN) { E(acc, cur, wr, wc, fr, fq); S.done(cur); }
        if (!has_next) break;
#pragma unroll
        for (int a = 0; a < 2; ++a)
#pragma unroll
            for (int b = 0; b < 2; ++b)
#pragma unroll
                for (int m = 0; m < 4; ++m)
#pragma unroll
                    for (int n = 0; n < 2; ++n) acc[a][b][m][n] = (f32x4){0.f, 0.f, 0.f, 0.f};
        cur = nxt; cA = nA; cB = nB; ++ui;
        if constexpr (ALIGN_EPI) { if (wr == 1) PG8_BAR; }
    }
    PG8_WAIT_V(0);
    if constexpr (!ALIGN_EPI) { if (wr == 0) PG8_BAR; }
    PG8_BAR;
    if constexpr (Epi::AFTER_DRAIN) { E.fused(acc, cur, wr, wc, fr, fq, lds, wid, lane); S.done(cur); }
#undef PG8_SA
#undef PG8_SB
#undef PG8_STAGE
#undef PG8_LDA
#undef PG8_LDB
#undef PG8_MMA
#undef PG8_WAIT_V
#undef PG8_WAIT_L
#undef PG8_BAR
#undef PG8_SCHED
}
}

#define GAS __attribute__((address_space(1)))
#define LAS __attribute__((address_space(3)))
typedef unsigned short bf16;
typedef unsigned v4u __attribute__((ext_vector_type(4)));
typedef float f32x4 __attribute__((ext_vector_type(4)));
typedef short bf16x8 __attribute__((ext_vector_type(8)));
typedef GAS unsigned gu32;
typedef GAS unsigned long long gu64;
#define RLX_AGENT __ATOMIC_RELAXED, __HIP_MEMORY_SCOPE_AGENT
#define LDS_WAIT() asm volatile("s_waitcnt lgkmcnt(0)" ::: "memory")
#define VM_WAIT() asm volatile("s_waitcnt vmcnt(0)" ::: "memory")
__device__ __forceinline__ unsigned long long rt() { return __builtin_amdgcn_s_memrealtime(); }
__device__ __forceinline__ unsigned f2bf(float f) { unsigned u = __builtin_bit_cast(unsigned, f); return (u + 0x7fffu + ((u >> 16) & 1u)) >> 16; }
__device__ __forceinline__ unsigned pk2(float lo, float hi) { return f2bf(lo) | (f2bf(hi) << 16); }

#define XB_TMO      128
#define XB_XCNT(j)  (256  + 64 * (j))
#define XB_XSUB(j)  (1280 + 64 * (j))
#define XB_XGEN(j)  (2304 + 64 * (j))
#define XB_TOP      3328
#define XB_TOPGEN   3392
#define XCD_BAR_WORDS 3456
#define XB_SPIN_CAP (1u << 18)

__device__ __forceinline__ unsigned xb_ld(unsigned* p)              { return __hip_atomic_load(p, __ATOMIC_RELAXED, __HIP_MEMORY_SCOPE_AGENT); }
__device__ __forceinline__ unsigned xb_add(unsigned* p, unsigned v) { return __hip_atomic_fetch_add(p, v, __ATOMIC_RELAXED, __HIP_MEMORY_SCOPE_AGENT); }
__device__ __forceinline__ unsigned xb_xcc_id() { return (unsigned)__builtin_amdgcn_s_getreg((3 << 11) | 20) & 0xFu; }
#define XB_SPIN(cond, bar) do { unsigned _sp = 0; while (cond) { __builtin_amdgcn_s_sleep(1); \
    if ((++_sp & 255u) == 0u) { if (xb_ld(&(bar)[XB_TMO])) break; if (_sp > XB_SPIN_CAP) { atomicAdd(&(bar)[XB_TMO], 1u); break; } } } } while (0)

struct XcdBarrier {
    unsigned* bar; unsigned x;
    volatile LAS unsigned* st;
};

__device__ __forceinline__ XcdBarrier xcd_barrier_post(unsigned* bar, volatile LAS unsigned* st) {
    XcdBarrier b; b.bar = bar; b.x = xb_xcc_id(); b.st = st;
    if (threadIdx.x == 0) (void)xb_add(&bar[XB_XCNT(b.x)], 1u);
    return b;
}
__device__ __forceinline__ void xcd_barrier_complete(unsigned* bar, unsigned x, unsigned& nloc, unsigned& nx) {
    const unsigned G = gridDim.x * gridDim.y * gridDim.z;
    unsigned sum, cnt, mine, sp = 0u;
    for (;;) {
        sum = 0u; cnt = 0u; mine = 0u;
#pragma unroll
        for (unsigned j = 0; j < 16; ++j) { const unsigned c = xb_ld(&bar[XB_XCNT(j)]); sum += c; cnt += (c > 0u) ? 1u : 0u; mine = (j == x) ? c : mine; }
        if (sum == G) break;
        __builtin_amdgcn_s_sleep(1);
        if ((++sp & 255u) == 0u) { if (xb_ld(&bar[XB_TMO])) break; if (sp > XB_SPIN_CAP) { atomicAdd(&bar[XB_TMO], 1u); break; } }
    }
    nloc = mine > 0u ? mine : 1u; nx = cnt > 0u ? cnt : 1u;
}

__device__ __forceinline__ void xcd_barrier(const XcdBarrier& b) {
    asm volatile("s_waitcnt vmcnt(0)" ::: "memory");
    __syncthreads();
    if (threadIdx.x == 0) {
        unsigned* bar = b.bar;
        __builtin_amdgcn_s_waitcnt(0);
        unsigned nloc = b.st[0], nx = b.st[1];
        if (nloc == 0u) { xcd_barrier_complete(bar, b.x, nloc, nx); b.st[0] = nloc; b.st[1] = nx; }
        const unsigned old = xb_add(&bar[XB_XSUB(b.x)], 1u);
        const unsigned gen = old / nloc;
        if (old + 1u == (gen + 1u) * nloc) {
            __builtin_amdgcn_fence(__ATOMIC_RELEASE, "agent");
            asm volatile("s_waitcnt vmcnt(0)" ::: "memory");
            const unsigned og = xb_add(&bar[XB_TOP], 1u);
            const unsigned tg = og / nx;
            if (og + 1u == (tg + 1u) * nx) xb_add(&bar[XB_TOPGEN], 1u);
            else XB_SPIN(xb_ld(&bar[XB_TOPGEN]) == tg, bar);
            __builtin_amdgcn_fence(__ATOMIC_ACQUIRE, "agent");
            xb_add(&bar[XB_XGEN(b.x)], 1u);
            asm volatile("s_waitcnt vmcnt(0)" ::: "memory");
        } else {
            XB_SPIN(xb_ld(&bar[XB_XGEN(b.x)]) == gen, bar);
            __builtin_amdgcn_fence(__ATOMIC_ACQUIRE, "agent");
            asm volatile("s_waitcnt vmcnt(0)" ::: "memory");
        }
    }
    __syncthreads();
}

constexpr int NWAVES = 8;
constexpr int DM = 2048, SEQ = 16384, CTXL = 256, DFF = 5632, NB = 2;
constexpr int TL = NB * SEQ;
constexpr int TC = NB * CTXL;
constexpr int T = TL + TC;
constexpr int NMOD = 9 * DM;
constexpr int NIN = 12096, NPROJ = 6144;
constexpr float EPSN = 1e-6f;
constexpr int PC_RX = 0, PC_RG = 1024, PC_DQ = 2048, PC_DK = 3072, PC_DV = 4096, PC_QC = 5120, PC_KVC = 5632, PC_KR = 5888;
enum { I_X = 0, I_C, I_CTX, I_CCTX, I_WMOD, I_BMOD, I_NORMG, I_WG, I_WU, I_WD, I_WIN, I_CONVW, I_CONVB, I_WA, I_BA, I_WX, I_BX, I_LAM,
       I_QCN, I_KVCN, I_WUQ, I_WUKV, I_QN, I_KN, I_DQN, I_DKN, I_DLAM, I_DON, I_BP, I_WOUT, N_INPUTS };

constexpr size_t MiB = 1u << 20;
constexpr size_t WS_CTL = 0, CTL_ZERO_BYTES = 1 * MiB;
constexpr size_t WS_MOD = 1 * MiB;
constexpr size_t WS_XC = 2 * MiB;
constexpr size_t WS_AGG = 6 * MiB;
constexpr size_t WS_LAC = 8 * MiB + 512 * 1024;
constexpr size_t WS_ROPE = 9 * MiB;
constexpr size_t WS_W = 13 * MiB;
constexpr size_t W_GU = 0, W_GU_SZ = (size_t)11264 * 2048 * 2;
constexpr size_t W_D = W_GU + 2 * W_GU_SZ, W_D_SZ = (size_t)2048 * 5632 * 2;
constexpr size_t W_IN = W_D + 2 * W_D_SZ, W_IN_SZ = (size_t)6144 * 2048 * 2;
constexpr size_t W_GT = W_IN + W_IN_SZ;
constexpr size_t W_BP = W_GT + W_IN_SZ, W_BP_SZ = (size_t)2048 * 1024 * 2;
constexpr size_t W_OUT = W_BP + 3 * W_BP_SZ;
constexpr size_t W_UQ = W_OUT + (size_t)2048 * 2048 * 2;
constexpr size_t W_UKV = W_UQ + (size_t)1536 * 512 * 2;
constexpr size_t W_LRU = W_UKV + (size_t)2048 * 256 * 2;
constexpr size_t W_END = W_LRU + (size_t)32 * 128 * 128 * 2;
static_assert(W_END <= 204 * MiB, "weights");
constexpr size_t WS_H = WS_W + 204 * MiB;
constexpr size_t WS_PROJ = WS_H + 130 * MiB;
constexpr size_t WS_QRAW = WS_PROJ + 390 * MiB;
constexpr size_t WS_KVRAW = WS_QRAW + 98 * MiB;
constexpr size_t WS_KN = WS_KVRAW + 130 * MiB;
constexpr size_t WS_O12 = WS_KN + 98 * MiB;
constexpr size_t WS_GATES = WS_QRAW;
constexpr size_t WS_BB = WS_O12 + 130 * MiB;
constexpr size_t WS_WAGG = WS_BB + 65 * MiB;
constexpr size_t WS_END = WS_WAGG + 18 * MiB;
static_assert(WS_GATES + 390 * MiB <= WS_BB, "gates overlay");
constexpr int CW_TMO = 0, CW_CODE = 1, CW_BAR = 4096;

constexpr int RING_OFF = 0, RING_BYTES = 131072;
constexpr int LDSCTL_OFF = RING_BYTES, MISC_OFF = LDSCTL_OFF + 320;
constexpr int LRU_SIDE_OFF = 132096;
constexpr int LRU_CW_OFF = LRU_SIDE_OFF + 16384;
constexpr int LRU_CB_OFF = LRU_CW_OFF + 2560;
constexpr int LDS_BYTES = 163840;
struct Args { const float* in[N_INPUTS]; float* out; unsigned char* ws; int ph_lo, ph_hi; };
struct Frame {
    LAS unsigned char* lds;
    volatile LAS unsigned* MISC;
    gu32* ctl;
    int tid, lane, wave, G;
};
__device__ __forceinline__ float wave_sum(float v) {
#pragma unroll
    for (int o = 1; o < 64; o <<= 1) v += __shfl_xor(v, o);
    return v;
}
__device__ __forceinline__ void transpose_item(const float* W, int ldw, bf16* WT, int ldt, int k0, int n0, int drow0, LAS float* scr, int lane) {
    float v[32];
    { const float* src = W + (size_t)(k0 + (lane >> 5)) * ldw + n0 + (lane & 31);
#pragma unroll
      for (int i = 0; i < 32; ++i) v[i] = src[(size_t)(2 * i) * ldw]; }
#pragma unroll
    for (int i = 0; i < 32; ++i) { const int kk = 2 * i + (lane >> 5); scr[kk * 33 + (lane & 31)] = v[i]; }
    LDS_WAIT(); asm volatile("" ::: "memory");
    const int c = lane & 7;
#pragma unroll
    for (int j = 0; j < 4; ++j) { const int n = (lane >> 3) + 8 * j; const LAS float* s = scr + (8 * c) * 33 + n;
        v4u o; o.x = pk2(s[0 * 33], s[1 * 33]); o.y = pk2(s[2 * 33], s[3 * 33]); o.z = pk2(s[4 * 33], s[5 * 33]); o.w = pk2(s[6 * 33], s[7 * 33]);
        *(GAS v4u*)(WT + (size_t)(drow0 + n) * ldt + k0 + 8 * c) = o; }
    LDS_WAIT(); asm volatile("" ::: "memory");
}
__device__ __forceinline__ int win_map(int n0) {
    if (n0 < 2048) return n0;
    if (n0 < 2560) return PC_QC + (n0 - 2048);
    if (n0 < 2816) return PC_KVC + (n0 - 2560);
    if (n0 < 2880) return PC_KR + (n0 - 2816);
    if (n0 < 3904) return PC_DQ + (n0 - 2880);
    if (n0 < 4928) return PC_DK + (n0 - 3904);
    return PC_DV + (n0 - 4928);
}
__device__ __forceinline__ void conv_phase(Frame& F, const Args& a, int l) {
    LAS float* scr = (LAS float*)(F.lds + RING_OFF + F.wave * 16384);
    unsigned char* wb = a.ws + WS_W;
    const int gw = blockIdx.x * NWAVES + F.wave, NGW = F.G * NWAVES;
    constexpr int I_GU = (DM / 64) * (DFF / 32);
    constexpr int I_DN = (DFF / 64) * (DM / 32);
    constexpr int I_IN = (DM / 64) * (NIN / 32);
    constexpr int I_BPJ = (1024 / 64) * (DM / 32);
    constexpr int I_WO = (DM / 64) * (DM / 32);
    constexpr int I_UQ = (512 / 64) * (1536 / 32);
    constexpr int I_UKV = (256 / 64) * (2048 / 32);
    constexpr int I_LRU = 32 * 8;
    constexpr int NITEMS = 4 * I_GU + 2 * I_DN + I_IN + 3 * I_BPJ + I_WO + I_UQ + I_UKV + I_LRU;
    { const float* lam = a.in[I_LAM] + (size_t)l * 2048; float* LAC = (float*)(a.ws + WS_LAC);
      for (int i = blockIdx.x * (NWAVES * 64) + F.tid; i < 2048; i += F.G * NWAVES * 64) LAC[i] = -8.f * 1.4426950408889634f * log1pf(expf(-lam[i])); }
    for (int it = gw; it < NITEMS; it += NGW) {
        int r = it;
        if (r < 4 * I_GU) { const int mat = r / I_GU, s = mat & 1, isup = mat >> 1; r -= mat * I_GU; const int nblk = DFF / 32, k0 = 64 * (r / nblk), n0 = 32 * (r % nblk);
            const float* W = a.in[isup ? I_WU : I_WG] + (size_t)(l * 2 + s) * DM * DFF;
            transpose_item(W, DFF, (bf16*)(wb + W_GU + s * W_GU_SZ), DM, k0, n0, (n0 >> 7) * 256 + (n0 & 127) + isup * 128, scr, F.lane); continue; }
        r -= 4 * I_GU;
        if (r < 2 * I_DN) { const int s = r / I_DN; r -= s * I_DN; const int nblk = DM / 32, k0 = 64 * (r / nblk), n0 = 32 * (r % nblk);
            transpose_item(a.in[I_WD] + (size_t)(l * 2 + s) * DFF * DM, DM, (bf16*)(wb + W_D + s * W_D_SZ), DFF, k0, n0, n0, scr, F.lane); continue; }
        r -= 2 * I_DN;
        if (r < I_IN) { const int nblk = NIN / 32, k0 = 64 * (r / nblk), n0 = 32 * (r % nblk);
            const bool gt = n0 >= 5952;
            transpose_item(a.in[I_WIN] + (size_t)l * DM * NIN, NIN, (bf16*)(wb + (gt ? W_GT : W_IN)), DM, k0, n0, gt ? n0 - 5952 : win_map(n0), scr, F.lane); continue; }
        r -= I_IN;
        if (r < 3 * I_BPJ) { const int j = r / I_BPJ; r -= j * I_BPJ; const int nblk = DM / 32, k0 = 64 * (r / nblk), n0 = 32 * (r % nblk);
            transpose_item(a.in[I_BP] + (size_t)(l * 3 + j) * 1024 * DM, DM, (bf16*)(wb + W_BP + j * W_BP_SZ), 1024, k0, n0, n0, scr, F.lane); continue; }
        r -= 3 * I_BPJ;
        if (r < I_WO) { const int nblk = DM / 32, k0 = 64 * (r / nblk), n0 = 32 * (r % nblk);
            transpose_item(a.in[I_WOUT] + (size_t)l * DM * DM, DM, (bf16*)(wb + W_OUT), DM, k0, n0, n0, scr, F.lane); continue; }
        r -= I_WO;
        if (r < I_UQ) { const int nblk = 1536 / 32, k0 = 64 * (r / nblk), n0 = 32 * (r % nblk);
            transpose_item(a.in[I_WUQ] + (size_t)l * 512 * 1536, 1536, (bf16*)(wb + W_UQ), 512, k0, n0, n0, scr, F.lane); continue; }
        r -= I_UQ;
        if (r < I_UKV) { const int nblk = 2048 / 32, k0 = 64 * (r / nblk), n0 = 32 * (r % nblk);
            transpose_item(a.in[I_WUKV] + (size_t)l * 256 * 2048, 2048, (bf16*)(wb + W_UKV), 256, k0, n0, n0, scr, F.lane); continue; }
        r -= I_UKV;
        { const int mi = r >> 3, sub = r & 7, k0 = 64 * (sub >> 2), n0 = 32 * (sub & 3);
          const int d = mi >> 4, mat = (mi >> 3) & 1, blk = mi & 7;
          const float* W = a.in[mat ? I_WX : I_WA] + (size_t)((l * 2 + d) * 8 + blk) * 128 * 128;
          transpose_item(W, 128, (bf16*)(wb + W_LRU) + (size_t)mi * 128 * 128, 128, k0, n0, n0, scr, F.lane); }
    }
}
__device__ __forceinline__ void mod_phase(Frame& F, const Args& a) {
    LAS float* S = (LAS float*)(F.lds + RING_OFF);
    LAS f32x4* red = (LAS f32x4*)(F.lds + RING_OFF + 3 * 2048 * 4);
    for (int i = F.tid; i < 3 * DM; i += NWAVES * 64) { const int r = i / DM, k = i % DM; const float v = r < 2 ? a.in[I_C][r * DM + k] : a.in[I_CCTX][k]; S[i] = v * __builtin_amdgcn_rcpf(1.f + __builtin_amdgcn_exp2f(-1.4426950408889634f * v)); }
    __syncthreads();
    float* MOD = (float*)(a.ws + WS_MOD);
    for (int unit = blockIdx.x; unit < 2 * 72; unit += F.G) {
        const int l = unit / 72, nb = unit % 72;
        const float* W = a.in[I_WMOD] + (size_t)l * DM * NMOD + nb * 256 + F.lane * 4;
        f32x4 a0 = {0.f, 0.f, 0.f, 0.f}, a1 = a0, a2 = a0;
        const int kb = F.wave * 256;
#pragma unroll 16
        for (int k = kb; k < kb + 256; ++k) { const f32x4 w = *(const f32x4*)(W + (size_t)k * NMOD); a0 += w * S[k]; a1 += w * S[DM + k]; a2 += w * S[2 * DM + k]; }
        red[(F.wave * 3 + 0) * 64 + F.lane] = a0; red[(F.wave * 3 + 1) * 64 + F.lane] = a1; red[(F.wave * 3 + 2) * 64 + F.lane] = a2;
        __syncthreads();
        for (int idx = F.tid; idx < 3 * 256; idx += NWAVES * 64) { const int r = idx >> 8, col = idx & 255; float s = a.in[I_BMOD][l * NMOD + nb * 256 + col];
#pragma unroll
            for (int w = 0; w < 8; ++w) s += ((LAS float*)red)[((w * 3 + r) * 64 + (col >> 2)) * 4 + (col & 3)];
            MOD[(size_t)(l * 3 + r) * NMOD + nb * 256 + col] = s; }
        __syncthreads();
    }
}
__device__ __forceinline__ void norm_phase(Frame& F, const Args& a, int l, int s, const float* xl, const float* xc, const float* part = nullptr, int ns = 0, float* xc_wb = nullptr) {
    const int gw = blockIdx.x * NWAVES + F.wave, NGW = F.G * NWAVES;
    const float* g = a.in[I_NORMG] + (size_t)(l * 3 + s) * DM;
    const float* MOD = (const float*)(a.ws + WS_MOD);
    bf16* H = (bf16*)(a.ws + WS_H);
    for (int m = gw; m < T; m += NGW) {
        const float* src = m < TL ? xl + (size_t)m * DM : xc + (size_t)(m - TL) * DM;
        const int mrow = m < SEQ ? 0 : (m < TL ? 1 : 2);
        const float* mp = MOD + (size_t)(l * 3 + mrow) * NMOD + (size_t)(3 * s) * DM;
        const GAS f32x4* xr = (const GAS f32x4*)src + F.lane;
        f32x4 v[8]; float ss = 0.f;
#pragma unroll
        for (int j = 0; j < 8; ++j) v[j] = xr[64 * j];
        f32x4 gv[8], sc[8], sh[8];
#pragma unroll
        for (int j = 0; j < 8; ++j) { const int col = F.lane * 4 + 256 * j; gv[j] = *(const f32x4*)(g + col); sc[j] = *(const f32x4*)(mp + col); sh[j] = *(const f32x4*)(mp + DM + col); }
        if (part && m >= TL) {
            for (int sl = 0; sl < ns; ++sl) { const GAS f32x4* pr = (const GAS f32x4*)(part + (size_t)sl * (512 * 2048) + (size_t)(m - TL) * DM) + F.lane;
                f32x4 tp[8];
#pragma unroll
                for (int j = 0; j < 8; ++j) tp[j] = pr[64 * j];
                __builtin_amdgcn_sched_barrier(0);
#pragma unroll
                for (int j = 0; j < 8; ++j) v[j] += tp[j]; }
            GAS f32x4* wb = (GAS f32x4*)(xc_wb + (size_t)(m - TL) * DM) + F.lane;
#pragma unroll
            for (int j = 0; j < 8; ++j) wb[64 * j] = v[j];
        }
#pragma unroll
        for (int j = 0; j < 8; ++j) ss += (v[j].x * v[j].x + v[j].y * v[j].y) + (v[j].z * v[j].z + v[j].w * v[j].w);
        const float rstd = 1.0f / sqrtf(wave_sum(ss) * (1.f / DM) + EPSN);
        GAS unsigned long long* o8 = (GAS unsigned long long*)(H + (size_t)m * DM) + F.lane;
#pragma unroll
        for (int j = 0; j < 8; ++j) { const int col = F.lane * 4 + 256 * j;
            const f32x4 o = v[j] * rstd * gv[j] * (sc[j] + 1.0f) + sh[j];
            o8[64 * j] = (unsigned long long)pk2(o.x, o.y) | ((unsigned long long)pk2(o.z, o.w) << 32); }
    }
}
using pg8::sigmoid_f; using pg8::silu_f; using pg8::gelu_tanh_f;
typedef float f32x16 __attribute__((ext_vector_type(16)));
typedef float f32x2v __attribute__((ext_vector_type(2)));

__device__ __forceinline__ int crow16(int r, int hi) { return (r & 3) + 8 * (r >> 2) + 4 * hi; }
__device__ __forceinline__ float bfbits2f(unsigned short b) { return __uint_as_float((unsigned)b << 16); }
template <bool PASS2> __device__ __forceinline__ void lru_phase(Frame& F, const Args& a, int l) {
    bf16* PROJ = (bf16*)(a.ws + WS_PROJ);
    float* AGG = (float*)(a.ws + WS_AGG);
    float* WAGG_G = (float*)(a.ws + WS_WAGG);
    const bf16* WL = (const bf16*)(a.ws + WS_W + W_LRU);
    const float* convw = a.in[I_CONVW] + (size_t)l * 4 * 1024;
    const float* convb = a.in[I_CONVB] + (size_t)l * 1024;
    const float* ba = a.in[I_BA] + (size_t)l * 2 * 1024;
    const float* bx = a.in[I_BX] + (size_t)l * 2 * 1024;
    const float* lam = a.in[I_LAM] + (size_t)l * 2 * 1024;
    LAS f32x2v* WAGG = (LAS f32x2v*)(F.lds + LRU_SIDE_OFF);
    LAS float* HW = (LAS float*)(F.lds + LRU_SIDE_OFF);
    const float* LAC = (const float*)(a.ws + WS_LAC);
    int nb_loaded = -1;
    const int lane = F.lane, tok = lane & 31, hi = lane >> 5, wave = F.wave;
    const int nunits = (PASS2 && l == 1) ? 128 * 8 : 130 * 8;
    for (int unit = blockIdx.x; unit < nunits; unit += F.G) {
        const int pm = unit >> 3, nb = unit & 7;
        const bool isl = pm < 128;
        const int b = isl ? (pm >> 6) : (pm - 128);
        const int jj = isl ? (pm & 63) : 0;
        const int len = isl ? SEQ : CTXL;
        const int pos = (isl ? jj * 256 : 0) + wave * 32 + tok;
        const size_t m = (size_t)pm * 256 + wave * 32 + tok;
        if (nb != nb_loaded) {
            __syncthreads();
#pragma unroll 1
            for (int hb = 0; hb < 2; ++hb) { v4u wv_[8];
#pragma unroll
              for (int i = 0; i < 8; ++i) { const int q = F.tid + (hb * 8 + i) * (NWAVES * 64), mi = q >> 11, n = (q >> 4) & 127, c = q & 15;
                  wv_[i] = *(const v4u*)(WL + ((size_t)(mi * 8 + nb) * 128 + n) * 128 + c * 8); }
#pragma unroll
              for (int i = 0; i < 8; ++i) { const int q = F.tid + (hb * 8 + i) * (NWAVES * 64), mi = q >> 11, n = (q >> 4) & 127, c = q & 15;
                  *(LAS v4u*)(F.lds + RING_OFF + mi * 32768 + n * 256 + ((c ^ (n & 15)) << 4)) = wv_[i]; } }
            for (int q = F.tid; q < 640; q += NWAVES * 64) { const int r = q >> 7, ch = q & 127;
                ((LAS float*)(F.lds + LRU_CW_OFF))[q] = r < 4 ? convw[r * 1024 + nb * 128 + ch] : convb[nb * 128 + ch]; }
            for (int q = F.tid; q < 768; q += NWAVES * 64) { const int d_ = q / 384, wh = (q % 384) >> 7, ch = q & 127;
                const float* sp = wh == 0 ? ba : (wh == 1 ? bx : LAC);
                ((LAS float*)(F.lds + LRU_CB_OFF))[q] = sp[d_ * 1024 + nb * 128 + ch]; }
            nb_loaded = nb; __syncthreads();
        }
        float tm[4];
#pragma unroll
        for (int j = 0; j < 4; ++j) { const int p = pos + j - 2; tm[j] = (p >= 0 && p < len) ? 1.f : 0.f; }
        const bf16* rp[4];
#pragma unroll
        for (int j = 0; j < 4; ++j) { const long mm = (long)m + (tm[j] != 0.f ? (j - 2) : 0); rp[j] = PROJ + (size_t)mm * NPROJ + PC_RX + nb * 128 + 8 * hi; }
#define LRU_LD(R, G) do { _Pragma("unroll") for (int j_ = 0; j_ < 4; ++j_) { R[0][j_] = *(const v4u*)(rp[j_] + 16 * (2 * (G))); R[1][j_] = *(const v4u*)(rp[j_] + 16 * (2 * (G) + 1)); } } while (0)
        v4u rawA[2][4], rawB[2][4];
        LRU_LD(rawA, 0); LRU_LD(rawB, 1);
        __builtin_amdgcn_sched_barrier(0);
        if (PASS2) {
            if (F.tid < 256) {
                const int d = F.tid >> 7, ch = F.tid & 127, cg = nb * 128 + ch;
                const float* ag = AGG + ((size_t)(b * 2 + d) * 65) * 2048 + (size_t)cg * 2;
                const float* wg = WAGG_G + ((size_t)(pm * 8) * 2 + d) * 2048 + (size_t)cg * 2;
                f32x2v wv[8];
#pragma unroll
                for (int w = 0; w < 8; ++w) wv[w] = *(const f32x2v*)(wg + (size_t)w * 4096);
                float h = 0.f;
                if (isl) {
                    { const f32x2v v = *(const f32x2v*)(ag); h = v.y; }
                    if (d == 0) { for (int j = 0; j < jj; j += 8) { f32x2v v[8];
#pragma unroll
                            for (int k = 0; k < 8; ++k) { const int q = j + k < 63 ? j + k : 63; v[k] = *(const f32x2v*)(ag + (size_t)(1 + q) * 2048); }
#pragma unroll
                            for (int k = 0; k < 8; ++k) if (j + k < jj) h = v[k].x * h + v[k].y; } }
                    else { for (int j = 63; j > jj; j -= 8) { f32x2v v[8];
#pragma unroll
                            for (int k = 0; k < 8; ++k) { const int q = j - k > 0 ? j - k : 0; v[k] = *(const f32x2v*)(ag + (size_t)(1 + q) * 2048); }
#pragma unroll
                            for (int k = 0; k < 8; ++k) if (j - k > jj) h = v[k].x * h + v[k].y; } }
                }
                if (d == 0) { for (int w = 0; w < 8; ++w) { HW[(d * 8 + w) * 128 + ch] = h; h = wv[w].x * h + wv[w].y; } }
                else { for (int w = 7; w >= 0; --w) { HW[(d * 8 + w) * 128 + ch] = h; h = wv[w].x * h + wv[w].y; } }
            }
            __syncthreads();
        }
        bf16x8 xf[8];
        const LAS float* CW = (const LAS float*)(F.lds + LRU_CW_OFF);
#define LRU_CV(R, G) do { _Pragma("unroll") for (int k2_ = 0; k2_ < 2; ++k2_) { const int ks_ = 2 * (G) + k2_, cl = 16 * ks_ + 8 * hi; float xv[8]; \
            { const f32x4 b0 = *(const LAS f32x4*)(CW + 512 + cl), b1 = *(const LAS f32x4*)(CW + 512 + cl + 4); \
              xv[0] = b0.x; xv[1] = b0.y; xv[2] = b0.z; xv[3] = b0.w; xv[4] = b1.x; xv[5] = b1.y; xv[6] = b1.z; xv[7] = b1.w; } \
            _Pragma("unroll") for (int j = 0; j < 4; ++j) { const v4u raw_ = R[k2_][j]; \
                const f32x4 w0 = *(const LAS f32x4*)(CW + j * 128 + cl) * tm[j], w1 = *(const LAS f32x4*)(CW + j * 128 + cl + 4) * tm[j]; \
                xv[0] += w0.x * __uint_as_float(raw_.x << 16); xv[1] += w0.y * __uint_as_float(raw_.x & 0xffff0000u); \
                xv[2] += w0.z * __uint_as_float(raw_.y << 16); xv[3] += w0.w * __uint_as_float(raw_.y & 0xffff0000u); \
                xv[4] += w1.x * __uint_as_float(raw_.z << 16); xv[5] += w1.y * __uint_as_float(raw_.z & 0xffff0000u); \
                xv[6] += w1.z * __uint_as_float(raw_.w << 16); xv[7] += w1.w * __uint_as_float(raw_.w & 0xffff0000u); } \
            v4u p; p.x = pk2(xv[0], xv[1]); p.y = pk2(xv[2], xv[3]); p.z = pk2(xv[4], xv[5]); p.w = pk2(xv[6], xv[7]); \
            xf[ks_] = __builtin_bit_cast(bf16x8, p); } } while (0)
        {
            v4u rawC[2][4];
            LRU_LD(rawC, 2); __builtin_amdgcn_sched_barrier(0);
            LRU_CV(rawA, 0); __builtin_amdgcn_sched_barrier(0);
            LRU_LD(rawA, 3); __builtin_amdgcn_sched_barrier(0);
            LRU_CV(rawB, 1); __builtin_amdgcn_sched_barrier(0);
            LRU_CV(rawC, 2); __builtin_amdgcn_sched_barrier(0);
            LRU_CV(rawA, 3);
        }
#undef LRU_LD
#undef LRU_CV
        __builtin_amdgcn_sched_barrier(0);
#pragma unroll 1
        for (int mb = 0; mb < 4; ++mb) {
            const int cb = nb * 128 + 32 * mb;
            float xa[16];
            {
                const v4u e0 = __builtin_bit_cast(v4u, xf[0]), e1 = __builtin_bit_cast(v4u, xf[1]), e2 = __builtin_bit_cast(v4u, xf[2]), e3 = __builtin_bit_cast(v4u, xf[3]);
                const v4u e4 = __builtin_bit_cast(v4u, xf[4]), e5 = __builtin_bit_cast(v4u, xf[5]), e6 = __builtin_bit_cast(v4u, xf[6]), e7 = __builtin_bit_cast(v4u, xf[7]);
                const v4u va = mb == 0 ? e0 : (mb == 1 ? e2 : (mb == 2 ? e4 : e6)), vb = mb == 0 ? e1 : (mb == 1 ? e3 : (mb == 2 ? e5 : e7));
                const auto ra0 = __builtin_amdgcn_permlane32_swap(va.x, va.z, false, false); const auto ra1 = __builtin_amdgcn_permlane32_swap(va.y, va.w, false, false);
                const auto rb0 = __builtin_amdgcn_permlane32_swap(vb.x, vb.z, false, false); const auto rb1 = __builtin_amdgcn_permlane32_swap(vb.y, vb.w, false, false);
                unsigned lo32[4], hi32[4];
                lo32[0] = hi ? ra0[0] : va.x; hi32[0] = hi ? ra1[0] : va.y;
                lo32[1] = hi ? va.z : ra0[1]; hi32[1] = hi ? va.w : ra1[1];
                lo32[2] = hi ? rb0[0] : vb.x; hi32[2] = hi ? rb1[0] : vb.y;
                lo32[3] = hi ? vb.z : rb0[1]; hi32[3] = hi ? vb.w : rb1[1];
#pragma unroll
                for (int g = 0; g < 4; ++g) { xa[4 * g + 0] = __uint_as_float(lo32[g] << 16); xa[4 * g + 1] = __uint_as_float(lo32[g] & 0xffff0000u);
                    xa[4 * g + 2] = __uint_as_float(hi32[g] << 16); xa[4 * g + 3] = __uint_as_float(hi32[g] & 0xffff0000u); }
            }
            float hsum[16];
#pragma unroll
            for (int e = 0; e < 16; ++e) hsum[e] = 0.f;
#pragma unroll
            for (int d = 0; d < 2; ++d) {
                __builtin_amdgcn_sched_barrier(0);
                f32x16 ar = {}, ai = {};
                const int nrow = 32 * mb + tok;
                const LAS unsigned char* wra = F.lds + RING_OFF + (d * 2 + 0) * 32768 + nrow * 256;
                const LAS unsigned char* wri = F.lds + RING_OFF + (d * 2 + 1) * 32768 + nrow * 256;
#pragma unroll
                for (int ks = 0; ks < 8; ++ks) {
                    const int cofs = ((2 * ks + hi) ^ (nrow & 15)) << 4;
                    const bf16x8 fa = *(const LAS bf16x8*)(wra + cofs), fi = *(const LAS bf16x8*)(wri + cofs);
                    ar = __builtin_amdgcn_mfma_f32_32x32x16_bf16(fa, xf[ks], ar, 0, 0, 0);
                    ai = __builtin_amdgcn_mfma_f32_32x32x16_bf16(fi, xf[ks], ai, 0, 0, 0);
                }
                __builtin_amdgcn_sched_barrier(0);
                float ca[16], cu[16];
#pragma unroll
                for (int g = 0; g < 4; ++g) { const int c0 = cb + 8 * g + 4 * hi;
                    const LAS float* cbp = (const LAS float*)(F.lds + LRU_CB_OFF) + d * 384 + 32 * mb + 8 * g + 4 * hi;
                    const f32x4 vba = *(const LAS f32x4*)(cbp), vbx = *(const LAS f32x4*)(cbp + 128), vl = *(const LAS f32x4*)(cbp + 256);
#pragma unroll
                    for (int i = 0; i < 4; ++i) { const int e = 4 * g + i;
                        const float r = sigmoid_f(ar[e] + vba[i]), ig = sigmoid_f(ai[e] + vbx[i]);
                        const float la2 = r * vl[i];
                        const float av = __builtin_amdgcn_exp2f(la2);
                        ca[e] = av; cu[e] = __builtin_amdgcn_sqrtf(fmaxf(1.f - av * av, 0.f)) * (ig * xa[e]); }
                }
                __builtin_amdgcn_sched_barrier(0);
#define LRU_DPP_BLOCK(E0, BODY) asm(BODY \
                    : "+v"(cu[E0 + 0]), "+v"(cu[E0 + 1]), "+v"(cu[E0 + 2]), "+v"(cu[E0 + 3]), "+v"(cu[E0 + 4]), "+v"(cu[E0 + 5]), "+v"(cu[E0 + 6]), "+v"(cu[E0 + 7]), \
                      "+v"(ca[E0 + 0]), "+v"(ca[E0 + 1]), "+v"(ca[E0 + 2]), "+v"(ca[E0 + 3]), "+v"(ca[E0 + 4]), "+v"(ca[E0 + 5]), "+v"(ca[E0 + 6]), "+v"(ca[E0 + 7]))
#define LRU_SCAN_SHR \
                    "s_nop 4\n\t" \
                    "v_fmac_f32_dpp %0, %0, %8 row_shr:1 row_mask:0xf bank_mask:0xf\n\t" \
                    "v_mul_f32_dpp %8, %8, %8 row_shr:1 row_mask:0xf bank_mask:0xf\n\t" \
                    "v_fmac_f32_dpp %1, %1, %9 row_shr:1 row_mask:0xf bank_mask:0xf\n\t" \
                    "v_mul_f32_dpp %9, %9, %9 row_shr:1 row_mask:0xf bank_mask:0xf\n\t" \
                    "v_fmac_f32_dpp %2, %2, %10 row_shr:1 row_mask:0xf bank_mask:0xf\n\t" \
                    "v_mul_f32_dpp %10, %10, %10 row_shr:1 row_mask:0xf bank_mask:0xf\n\t" \
                    "v_fmac_f32_dpp %3, %3, %11 row_shr:1 row_mask:0xf bank_mask:0xf\n\t" \
                    "v_mul_f32_dpp %11, %11, %11 row_shr:1 row_mask:0xf bank_mask:0xf\n\t" \
                    "v_fmac_f32_dpp %4, %4, %12 row_shr:1 row_mask:0xf bank_mask:0xf\n\t" \
                    "v_mul_f32_dpp %12, %12, %12 row_shr:1 row_mask:0xf bank_mask:0xf\n\t" \
                    "v_fmac_f32_dpp %5, %5, %13 row_shr:1 row_mask:0xf bank_mask:0xf\n\t" \
                    "v_mul_f32_dpp %13, %13, %13 row_shr:1 row_mask:0xf bank_mask:0xf\n\t" \
                    "v_fmac_f32_dpp %6, %6, %14 row_shr:1 row_mask:0xf bank_mask:0xf\n\t" \
                    "v_mul_f32_dpp %14, %14, %14 row_shr:1 row_mask:0xf bank_mask:0xf\n\t" \
                    "v_fmac_f32_dpp %7, %7, %15 row_shr:1 row_mask:0xf bank_mask:0xf\n\t" \
                    "v_mul_f32_dpp %15, %15, %15 row_shr:1 row_mask:0xf bank_mask:0xf\n\t" \
                    "v_fmac_f32_dpp %0, %0, %8 row_shr:2 row_mask:0xf bank_mask:0xf\n\t" \
                    "v_mul_f32_dpp %8, %8, %8 row_shr:2 row_mask:0xf bank_mask:0xf\n\t" \
                    "v_fmac_f32_dpp %1, %1, %9 row_shr:2 row_mask:0xf bank_mask:0xf\n\t" \
                    "v_mul_f32_dpp %9, %9, %9 row_shr:2 row_mask:0xf bank_mask:0xf\n\t" \
                    "v_fmac_f32_dpp %2, %2, %10 row_shr:2 row_mask:0xf bank_mask:0xf\n\t" \
                    "v_mul_f32_dpp %10, %10, %10 row_shr:2 row_mask:0xf bank_mask:0xf\n\t" \
                    "v_fmac_f32_dpp %3, %3, %11 row_shr:2 row_mask:0xf bank_mask:0xf\n\t" \
                    "v_mul_f32_dpp %11, %11, %11 row_shr:2 row_mask:0xf bank_mask:0xf\n\t" \
                    "v_fmac_f32_dpp %4, %4, %12 row_shr:2 row_mask:0xf bank_mask:0xf\n\t" \
                    "v_mul_f32_dpp %12, %12, %12 row_shr:2 row_mask:0xf bank_mask:0xf\n\t" \
                    "v_fmac_f32_dpp %5, %5, %13 row_shr:2 row_mask:0xf bank_mask:0xf\n\t" \
                    "v_mul_f32_dpp %13, %13, %13 row_shr:2 row_mask:0xf bank_mask:0xf\n\t" \
                    "v_fmac_f32_dpp %6, %6, %14 row_shr:2 row_mask:0xf bank_mask:0xf\n\t" \
                    "v_mul_f32_dpp %14, %14, %14 row_shr:2 row_mask:0xf bank_mask:0xf\n\t" \
                    "v_fmac_f32_dpp %7, %7, %15 row_shr:2 row_mask:0xf bank_mask:0xf\n\t" \
                    "v_mul_f32_dpp %15, %15, %15 row_shr:2 row_mask:0xf bank_mask:0xf\n\t" \
                    "v_fmac_f32_dpp %0, %0, %8 row_shr:4 row_mask:0xf bank_mask:0xf\n\t" \
                    "v_mul_f32_dpp %8, %8, %8 row_shr:4 row_mask:0xf bank_mask:0xf\n\t" \
                    "v_fmac_f32_dpp %1, %1, %9 row_shr:4 row_mask:0xf bank_mask:0xf\n\t" \
                    "v_mul_f32_dpp %9, %9, %9 row_shr:4 row_mask:0xf bank_mask:0xf\n\t" \
                    "v_fmac_f32_dpp %2, %2, %10 row_shr:4 row_mask:0xf bank_mask:0xf\n\t" \
                    "v_mul_f32_dpp %10, %10, %10 row_shr:4 row_mask:0xf bank_mask:0xf\n\t" \
                    "v_fmac_f32_dpp %3, %3, %11 row_shr:4 row_mask:0xf bank_mask:0xf\n\t" \
                    "v_mul_f32_dpp %11, %11, %11 row_shr:4 row_mask:0xf bank_mask:0xf\n\t" \
                    "v_fmac_f32_dpp %4, %4, %12 row_shr:4 row_mask:0xf bank_mask:0xf\n\t" \
                    "v_mul_f32_dpp %12, %12, %12 row_shr:4 row_mask:0xf bank_mask:0xf\n\t" \
                    "v_fmac_f32_dpp %5, %5, %13 row_shr:4 row_mask:0xf bank_mask:0xf\n\t" \
                    "v_mul_f32_dpp %13, %13, %13 row_shr:4 row_mask:0xf bank_mask:0xf\n\t" \
                    "v_fmac_f32_dpp %6, %6, %14 row_shr:4 row_mask:0xf bank_mask:0xf\n\t" \
                    "v_mul_f32_dpp %14, %14, %14 row_shr:4 row_mask:0xf bank_mask:0xf\n\t" \
                    "v_fmac_f32_dpp %7, %7, %15 row_shr:4 row_mask:0xf bank_mask:0xf\n\t" \
                    "v_mul_f32_dpp %15, %15, %15 row_shr:4 row_mask:0xf bank_mask:0xf\n\t" \
                    "v_fmac_f32_dpp %0, %0, %8 row_shr:8 row_mask:0xf bank_mask:0xf\n\t" \
                    "v_mul_f32_dpp %8, %8, %8 row_shr:8 row_mask:0xf bank_mask:0xf\n\t" \
                    "v_fmac_f32_dpp %1, %1, %9 row_shr:8 row_mask:0xf bank_mask:0xf\n\t" \
                    "v_mul_f32_dpp %9, %9, %9 row_shr:8 row_mask:0xf bank_mask:0xf\n\t" \
                    "v_fmac_f32_dpp %2, %2, %10 row_shr:8 row_mask:0xf bank_mask:0xf\n\t" \
                    "v_mul_f32_dpp %10, %10, %10 row_shr:8 row_mask:0xf bank_mask:0xf\n\t" \
                    "v_fmac_f32_dpp %3, %3, %11 row_shr:8 row_mask:0xf bank_mask:0xf\n\t" \
                    "v_mul_f32_dpp %11, %11, %11 row_shr:8 row_mask:0xf bank_mask:0xf\n\t" \
                    "v_fmac_f32_dpp %4, %4, %12 row_shr:8 row_mask:0xf bank_mask:0xf\n\t" \
                    "v_mul_f32_dpp %12, %12, %12 row_shr:8 row_mask:0xf bank_mask:0xf\n\t" \
                    "v_fmac_f32_dpp %5, %5, %13 row_shr:8 row_mask:0xf bank_mask:0xf\n\t" \
                    "v_mul_f32_dpp %13, %13, %13 row_shr:8 row_mask:0xf bank_mask:0xf\n\t" \
                    "v_fmac_f32_dpp %6, %6, %14 row_shr:8 row_mask:0xf bank_mask:0xf\n\t" \
                    "v_mul_f32_dpp %14, %14, %14 row_shr:8 row_mask:0xf bank_mask:0xf\n\t" \
                    "v_fmac_f32_dpp %7, %7, %15 row_shr:8 row_mask:0xf bank_mask:0xf\n\t" \
                    "v_mul_f32_dpp %15, %15, %15 row_shr:8 row_mask:0xf bank_mask:0xf\n\t" \
                    "s_nop 1"
#define LRU_SCAN_SHL \
                    "s_nop 4\n\t" \
                    "v_fmac_f32_dpp %0, %0, %8 row_shl:1 row_mask:0xf bank_mask:0xf\n\t" \
                    "v_mul_f32_dpp %8, %8, %8 row_shl:1 row_mask:0xf bank_mask:0xf\n\t" \
                    "v_fmac_f32_dpp %1, %1, %9 row_shl:1 row_mask:0xf bank_mask:0xf\n\t" \
                    "v_mul_f32_dpp %9, %9, %9 row_shl:1 row_mask:0xf bank_mask:0xf\n\t" \
                    "v_fmac_f32_dpp %2, %2, %10 row_shl:1 row_mask:0xf bank_mask:0xf\n\t" \
                    "v_mul_f32_dpp %10, %10, %10 row_shl:1 row_mask:0xf bank_mask:0xf\n\t" \
                    "v_fmac_f32_dpp %3, %3, %11 row_shl:1 row_mask:0xf bank_mask:0xf\n\t" \
                    "v_mul_f32_dpp %11, %11, %11 row_shl:1 row_mask:0xf bank_mask:0xf\n\t" \
                    "v_fmac_f32_dpp %4, %4, %12 row_shl:1 row_mask:0xf bank_mask:0xf\n\t" \
                    "v_mul_f32_dpp %12, %12, %12 row_shl:1 row_mask:0xf bank_mask:0xf\n\t" \
                    "v_fmac_f32_dpp %5, %5, %13 row_shl:1 row_mask:0xf bank_mask:0xf\n\t" \
                    "v_mul_f32_dpp %13, %13, %13 row_shl:1 row_mask:0xf bank_mask:0xf\n\t" \
                    "v_fmac_f32_dpp %6, %6, %14 row_shl:1 row_mask:0xf bank_mask:0xf\n\t" \
                    "v_mul_f32_dpp %14, %14, %14 row_shl:1 row_mask:0xf bank_mask:0xf\n\t" \
                    "v_fmac_f32_dpp %7, %7, %15 row_shl:1 row_mask:0xf bank_mask:0xf\n\t" \
                    "v_mul_f32_dpp %15, %15, %15 row_shl:1 row_mask:0xf bank_mask:0xf\n\t" \
                    "v_fmac_f32_dpp %0, %0, %8 row_shl:2 row_mask:0xf bank_mask:0xf\n\t" \
                    "v_mul_f32_dpp %8, %8, %8 row_shl:2 row_mask:0xf bank_mask:0xf\n\t" \
                    "v_fmac_f32_dpp %1, %1, %9 row_shl:2 row_mask:0xf bank_mask:0xf\n\t" \
                    "v_mul_f32_dpp %9, %9, %9 row_shl:2 row_mask:0xf bank_mask:0xf\n\t" \
                    "v_fmac_f32_dpp %2, %2, %10 row_shl:2 row_mask:0xf bank_mask:0xf\n\t" \
                    "v_mul_f32_dpp %10, %10, %10 row_shl:2 row_mask:0xf bank_mask:0xf\n\t" \
                    "v_fmac_f32_dpp %3, %3, %11 row_shl:2 row_mask:0xf bank_mask:0xf\n\t" \
                    "v_mul_f32_dpp %11, %11, %11 row_shl:2 row_mask:0xf bank_mask:0xf\n\t" \
                    "v_fmac_f32_dpp %4, %4, %12 row_shl:2 row_mask:0xf bank_mask:0xf\n\t" \
                    "v_mul_f32_dpp %12, %12, %12 row_shl:2 row_mask:0xf bank_mask:0xf\n\t" \
                    "v_fmac_f32_dpp %5, %5, %13 row_shl:2 row_mask:0xf bank_mask:0xf\n\t" \
                    "v_mul_f32_dpp %13, %13, %13 row_shl:2 row_mask:0xf bank_mask:0xf\n\t" \
                    "v_fmac_f32_dpp %6, %6, %14 row_shl:2 row_mask:0xf bank_mask:0xf\n\t" \
                    "v_mul_f32_dpp %14, %14, %14 row_shl:2 row_mask:0xf bank_mask:0xf\n\t" \
                    "v_fmac_f32_dpp %7, %7, %15 row_shl:2 row_mask:0xf bank_mask:0xf\n\t" \
                    "v_mul_f32_dpp %15, %15, %15 row_shl:2 row_mask:0xf bank_mask:0xf\n\t" \
                    "v_fmac_f32_dpp %0, %0, %8 row_shl:4 row_mask:0xf bank_mask:0xf\n\t" \
                    "v_mul_f32_dpp %8, %8, %8 row_shl:4 row_mask:0xf bank_mask:0xf\n\t" \
                    "v_fmac_f32_dpp %1, %1, %9 row_shl:4 row_mask:0xf bank_mask:0xf\n\t" \
                    "v_mul_f32_dpp %9, %9, %9 row_shl:4 row_mask:0xf bank_mask:0xf\n\t" \
                    "v_fmac_f32_dpp %2, %2, %10 row_shl:4 row_mask:0xf bank_mask:0xf\n\t" \
                    "v_mul_f32_dpp %10, %10, %10 row_shl:4 row_mask:0xf bank_mask:0xf\n\t" \
                    "v_fmac_f32_dpp %3, %3, %11 row_shl:4 row_mask:0xf bank_mask:0xf\n\t" \
                    "v_mul_f32_dpp %11, %11, %11 row_shl:4 row_mask:0xf bank_mask:0xf\n\t" \
                    "v_fmac_f32_dpp %4, %4, %12 row_shl:4 row_mask:0xf bank_mask:0xf\n\t" \
                    "v_mul_f32_dpp %12, %12, %12 row_shl:4 row_mask:0xf bank_mask:0xf\n\t" \
                    "v_fmac_f32_dpp %5, %5, %13 row_shl:4 row_mask:0xf bank_mask:0xf\n\t" \
                    "v_mul_f32_dpp %13, %13, %13 row_shl:4 row_mask:0xf bank_mask:0xf\n\t" \
                    "v_fmac_f32_dpp %6, %6, %14 row_shl:4 row_mask:0xf bank_mask:0xf\n\t" \
                    "v_mul_f32_dpp %14, %14, %14 row_shl:4 row_mask:0xf bank_mask:0xf\n\t" \
                    "v_fmac_f32_dpp %7, %7, %15 row_shl:4 row_mask:0xf bank_mask:0xf\n\t" \
                    "v_mul_f32_dpp %15, %15, %15 row_shl:4 row_mask:0xf bank_mask:0xf\n\t" \
                    "v_fmac_f32_dpp %0, %0, %8 row_shl:8 row_mask:0xf bank_mask:0xf\n\t" \
                    "v_mul_f32_dpp %8, %8, %8 row_shl:8 row_mask:0xf bank_mask:0xf\n\t" \
                    "v_fmac_f32_dpp %1, %1, %9 row_shl:8 row_mask:0xf bank_mask:0xf\n\t" \
                    "v_mul_f32_dpp %9, %9, %9 row_shl:8 row_mask:0xf bank_mask:0xf\n\t" \
                    "v_fmac_f32_dpp %2, %2, %10 row_shl:8 row_mask:0xf bank_mask:0xf\n\t" \
                    "v_mul_f32_dpp %10, %10, %10 row_shl:8 row_mask:0xf bank_mask:0xf\n\t" \
                    "v_fmac_f32_dpp %3, %3, %11 row_shl:8 row_mask:0xf bank_mask:0xf\n\t" \
                    "v_mul_f32_dpp %11, %11, %11 row_shl:8 row_mask:0xf bank_mask:0xf\n\t" \
                    "v_fmac_f32_dpp %4, %4, %12 row_shl:8 row_mask:0xf bank_mask:0xf\n\t" \
                    "v_mul_f32_dpp %12, %12, %12 row_shl:8 row_mask:0xf bank_mask:0xf\n\t" \
                    "v_fmac_f32_dpp %5, %5, %13 row_shl:8 row_mask:0xf bank_mask:0xf\n\t" \
                    "v_mul_f32_dpp %13, %13, %13 row_shl:8 row_mask:0xf bank_mask:0xf\n\t" \
                    "v_fmac_f32_dpp %6, %6, %14 row_shl:8 row_mask:0xf bank_mask:0xf\n\t" \
                    "v_mul_f32_dpp %14, %14, %14 row_shl:8 row_mask:0xf bank_mask:0xf\n\t" \
                    "v_fmac_f32_dpp %7, %7, %15 row_shl:8 row_mask:0xf bank_mask:0xf\n\t" \
                    "v_mul_f32_dpp %15, %15, %15 row_shl:8 row_mask:0xf bank_mask:0xf\n\t" \
                    "s_nop 1"
                if (d == 0) { LRU_DPP_BLOCK(0, LRU_SCAN_SHR); LRU_DPP_BLOCK(8, LRU_SCAN_SHR); }
                else        { LRU_DPP_BLOCK(0, LRU_SCAN_SHL); LRU_DPP_BLOCK(8, LRU_SCAN_SHL); }
#undef LRU_DPP_BLOCK
#undef LRU_SCAN_SHR
#undef LRU_SCAN_SHL
                {
                    const bool second = d == 0 ? ((lane & 16) != 0) : ((lane & 16) == 0);
#pragma unroll
                    for (int e = 0; e < 16; ++e) {
                        const int ia = __builtin_bit_cast(int, ca[e]), iu = __builtin_bit_cast(int, cu[e]);
                        const int ta0 = __builtin_amdgcn_readlane(ia, d == 0 ? 15 : 16), ta1 = __builtin_amdgcn_readlane(ia, d == 0 ? 47 : 48);
                        const int tu0 = __builtin_amdgcn_readlane(iu, d == 0 ? 15 : 16), tu1 = __builtin_amdgcn_readlane(iu, d == 0 ? 47 : 48);
                        const float ta = __builtin_bit_cast(float, hi ? ta1 : ta0), tu = __builtin_bit_cast(float, hi ? tu1 : tu0);
                        if (second) { cu[e] = ca[e] * tu + cu[e]; ca[e] = ca[e] * ta; }
                        if ((e & 1) == 1) __builtin_amdgcn_sched_barrier(0);
                    }
                }
                __builtin_amdgcn_sched_barrier(0);
                if (!PASS2) {
                    if (tok == (d == 0 ? 31 : 0)) {
                        float* wg = WAGG_G + ((size_t)(pm * 8 + wave) * 2 + d) * 2048;
#pragma unroll
                        for (int e = 0; e < 16; ++e) { const int ch = 32 * mb + crow16(e, hi); const f32x2v v = {ca[e], cu[e]};
                            WAGG[(d * 8 + wave) * 128 + ch] = v; *(f32x2v*)(wg + (size_t)(nb * 128 + ch) * 2) = v; }
                    }
                } else {
#pragma unroll
                    for (int e = 0; e < 16; ++e) { const float hin = HW[(d * 8 + wave) * 128 + 32 * mb + crow16(e, hi)]; hsum[e] += ca[e] * hin + cu[e]; }
                }
            }
            if (PASS2) {
#pragma unroll
                for (int g = 0; g < 4; ++g) { const int c0 = cb + 8 * g + 4 * hi;
                    unsigned long long* p = (unsigned long long*)(PROJ + m * NPROJ + PC_RG + c0);
                    const unsigned long long raw = *p; const unsigned lo32 = (unsigned)raw, hi32 = (unsigned)(raw >> 32);
                    const float y0 = hsum[4 * g + 0] * __uint_as_float(lo32 << 16), y1 = hsum[4 * g + 1] * __uint_as_float(lo32 & 0xffff0000u);
                    const float y2 = hsum[4 * g + 2] * __uint_as_float(hi32 << 16), y3 = hsum[4 * g + 3] * __uint_as_float(hi32 & 0xffff0000u);
                    *p = (unsigned long long)pk2(y0, y1) | ((unsigned long long)pk2(y2, y3) << 32); }
            }
        }
        if (!PASS2) {
            __syncthreads();
            if (F.tid < 256) {
                const int d = F.tid >> 7, ch = F.tid & 127;
                float A = 1.f, U = 0.f;
                if (d == 0) { for (int w = 0; w < 8; ++w) { const f32x2v v = WAGG[(d * 8 + w) * 128 + ch]; U = v.x * U + v.y; A = A * v.x; } }
                else { for (int w = 7; w >= 0; --w) { const f32x2v v = WAGG[(d * 8 + w) * 128 + ch]; U = v.x * U + v.y; A = A * v.x; } }
                const int ci = isl ? 1 + jj : 0;
                *(f32x2v*)(AGG + ((size_t)(b * 2 + d) * 65 + ci) * 2048 + (size_t)(nb * 128 + ch) * 2) = (f32x2v){A, U};
            }
        }
        __syncthreads();
    }
}
namespace att {
using bf16x8 = __attribute__((ext_vector_type(8))) short;
using s16x4  = __attribute__((ext_vector_type(4))) short;
using f32x16 = __attribute__((ext_vector_type(16))) float;
using u32x4  = __attribute__((ext_vector_type(4))) unsigned;
constexpr int QBLK = 32, KVBLK = 64, NW = 8;
constexpr float THR = 8.f;
#define ATT_SBAR() __builtin_amdgcn_sched_barrier(0)
__device__ __forceinline__ int crow(int r, int hi) { return (r & 3) + 8 * (r >> 2) + 4 * hi; }
__device__ __forceinline__ unsigned cvtpk(float lo, float hi) { return pg8::cvt_pk_bf16(lo, hi); }
__device__ __forceinline__ void partialSM(f32x16& p0, f32x16& p1, float& m_reg, float& mn, float& alpha) {
  float pmax = p0[0];
#pragma unroll
  for (int r = 1; r < 16; ++r) pmax = fmaxf(pmax, p0[r]);
#pragma unroll
  for (int r = 0; r < 16; ++r) pmax = fmaxf(pmax, p1[r]);
  { auto rr = __builtin_amdgcn_permlane32_swap(__float_as_uint(pmax), __float_as_uint(pmax), false, false);
    pmax = fmaxf(__uint_as_float(rr[0]), __uint_as_float(rr[1])); }
  if (__builtin_expect(__all(pmax - m_reg <= THR), 1)) { mn = m_reg; alpha = 1.f; }
  else { mn = fmaxf(m_reg, pmax); alpha = __builtin_amdgcn_exp2f(m_reg - mn); m_reg = mn; }
#pragma unroll
  for (int r = 0; r < 16; ++r) p0[r] = p0[r] - mn;
#pragma unroll
  for (int r = 0; r < 16; ++r) p1[r] = p1[r] - mn;
#pragma unroll
  for (int r = 0; r < 16; ++r) p0[r] = __builtin_amdgcn_exp2f(p0[r]);
}
__device__ __forceinline__ void finishSM(f32x16& p0, f32x16& p1, float alpha, float& l_reg, bf16x8& pa0, bf16x8& pa1, bf16x8& pa2, bf16x8& pa3) {
#pragma unroll
  for (int r = 0; r < 16; ++r) p1[r] = __builtin_amdgcn_exp2f(p1[r]);
  float ps = 0;
#pragma unroll
  for (int r = 0; r < 16; ++r) ps += p0[r];
#pragma unroll
  for (int r = 0; r < 16; ++r) ps += p1[r];
  { auto rr = __builtin_amdgcn_permlane32_swap(__float_as_uint(ps), __float_as_uint(ps), false, false);
    ps = __uint_as_float(rr[0]) + __uint_as_float(rr[1]); }
  l_reg = l_reg * alpha + ps;
#define ATT_PK4(P, BASE, OUT) do { unsigned a0 = cvtpk(P[BASE + 0], P[BASE + 1]), a1 = cvtpk(P[BASE + 2], P[BASE + 3]);   \
    unsigned b0 = cvtpk(P[BASE + 4], P[BASE + 5]), b1 = cvtpk(P[BASE + 6], P[BASE + 7]);                              \
    auto r0 = __builtin_amdgcn_permlane32_swap(a0, b0, false, false); auto r1 = __builtin_amdgcn_permlane32_swap(a1, b1, false, false); \
    u32x4 w = {r0[0], r1[0], r0[1], r1[1]}; OUT = *reinterpret_cast<bf16x8*>(&w); } while (0)
  ATT_PK4(p0, 0, pa0); ATT_PK4(p0, 8, pa1); ATT_PK4(p1, 0, pa2); ATT_PK4(p1, 8, pa3);
#undef ATT_PK4
}
template <int DQK> __device__ __forceinline__ int kswz(int row, int colB) { return row * (DQK * 2) + (colB ^ (((row >> 1) & 7) << 4)); }
template <int DQK> __device__ __forceinline__ void qkt(f32x16& p0, f32x16& p1, const __attribute__((address_space(3))) unsigned char* Ks, const bf16x8* qr, int r32, int hi) {
  p0 = f32x16{}; p1 = f32x16{};
#pragma unroll
  for (int d0 = 0; d0 < DQK / 16; ++d0) { const int cb = (d0 * 16 + hi * 8) * 2;
    const bf16x8 b0 = *(const __attribute__((address_space(3))) bf16x8*)(Ks + kswz<DQK>(r32, cb));
    const bf16x8 b1 = *(const __attribute__((address_space(3))) bf16x8*)(Ks + kswz<DQK>(32 + r32, cb));
    p0 = __builtin_amdgcn_mfma_f32_32x32x16_bf16(b0, qr[d0], p0, 0, 0, 0);
    p1 = __builtin_amdgcn_mfma_f32_32x32x16_bf16(b1, qr[d0], p1, 0, 0, 0); }
}
__device__ __forceinline__ int v_st(int k, int c) { const int kk = (k & ~0xC) | ((k & 4) << 1) | ((k & 8) >> 1); return ((kk >> 3) * 4 + (c >> 5)) * 512 + ((kk & 7) * 32 + (c & 31)) * 2; }
__device__ __forceinline__ int v_rd_base(int lane) { return ((lane & 3) << 3) | (((lane >> 2) & 3) << 6) | (((lane >> 4) & 1) << 5) | (((lane >> 5) & 1) << 8); }
constexpr int v_rd_off(int d0, int ks, int half) { return d0 * 512 + ks * 4096 + half * 2048; }
template <int OFF> __device__ __forceinline__ s16x4 tr_read(int vb) {
  s16x4 r; asm volatile("ds_read_b64_tr_b16 %0, %1 offset:%2" : "=&v"(r) : "v"(vb), "i"(OFF) : "memory"); return r;
}
template <int D0> __device__ __forceinline__ void pv_one(f32x16& od, int vb, bf16x8 pa0, bf16x8 pa1, bf16x8 pa2, bf16x8 pa3) {
  const s16x4 l0 = tr_read<v_rd_off(D0, 0, 0)>(vb), h0 = tr_read<v_rd_off(D0, 0, 1)>(vb), l1 = tr_read<v_rd_off(D0, 1, 0)>(vb), h1 = tr_read<v_rd_off(D0, 1, 1)>(vb);
  const s16x4 l2 = tr_read<v_rd_off(D0, 2, 0)>(vb), h2 = tr_read<v_rd_off(D0, 2, 1)>(vb), l3 = tr_read<v_rd_off(D0, 3, 0)>(vb), h3 = tr_read<v_rd_off(D0, 3, 1)>(vb);
  asm volatile("s_waitcnt lgkmcnt(0)" ::: "memory"); ATT_SBAR();
#define ATT_PK(L, H) (bf16x8){L[0], L[1], L[2], L[3], H[0], H[1], H[2], H[3]}
  od = __builtin_amdgcn_mfma_f32_32x32x16_bf16(pa0, ATT_PK(l0, h0), od, 0, 0, 0);
  od = __builtin_amdgcn_mfma_f32_32x32x16_bf16(pa1, ATT_PK(l1, h1), od, 0, 0, 0);
  od = __builtin_amdgcn_mfma_f32_32x32x16_bf16(pa2, ATT_PK(l2, h2), od, 0, 0, 0);
  od = __builtin_amdgcn_mfma_f32_32x32x16_bf16(pa3, ATT_PK(l3, h3), od, 0, 0, 0);
#undef ATT_PK
}
template <int D0, int H> __device__ __forceinline__ void pv_half(f32x16& od, int vb, bf16x8 pa, bf16x8 pb) {
  const s16x4 l0 = tr_read<v_rd_off(D0, 2 * H, 0)>(vb), h0 = tr_read<v_rd_off(D0, 2 * H, 1)>(vb), l1 = tr_read<v_rd_off(D0, 2 * H + 1, 0)>(vb), h1 = tr_read<v_rd_off(D0, 2 * H + 1, 1)>(vb);
  asm volatile("s_waitcnt lgkmcnt(0)" ::: "memory"); ATT_SBAR();
#define ATT_PK(L, H_) (bf16x8){L[0], L[1], L[2], L[3], H_[0], H_[1], H_[2], H_[3]}
  od = __builtin_amdgcn_mfma_f32_32x32x16_bf16(pa, ATT_PK(l0, h0), od, 0, 0, 0);
  od = __builtin_amdgcn_mfma_f32_32x32x16_bf16(pb, ATT_PK(l1, h1), od, 0, 0, 0);
#undef ATT_PK
}
template <int D0> __device__ __forceinline__ void pv_rd(s16x4 (&v)[8], int vb) {
  v[0] = tr_read<v_rd_off(D0, 0, 0)>(vb); v[1] = tr_read<v_rd_off(D0, 0, 1)>(vb); v[2] = tr_read<v_rd_off(D0, 1, 0)>(vb); v[3] = tr_read<v_rd_off(D0, 1, 1)>(vb);
  v[4] = tr_read<v_rd_off(D0, 2, 0)>(vb); v[5] = tr_read<v_rd_off(D0, 2, 1)>(vb); v[6] = tr_read<v_rd_off(D0, 3, 0)>(vb); v[7] = tr_read<v_rd_off(D0, 3, 1)>(vb);
}
__device__ __forceinline__ void pv_mf(f32x16& od, const s16x4 (&v)[8], bf16x8 pa0, bf16x8 pa1, bf16x8 pa2, bf16x8 pa3) {
#define ATT_PK(L, H) (bf16x8){L[0], L[1], L[2], L[3], H[0], H[1], H[2], H[3]}
  od = __builtin_amdgcn_mfma_f32_32x32x16_bf16(pa0, ATT_PK(v[0], v[1]), od, 0, 0, 0);
  od = __builtin_amdgcn_mfma_f32_32x32x16_bf16(pa1, ATT_PK(v[2], v[3]), od, 0, 0, 0);
  od = __builtin_amdgcn_mfma_f32_32x32x16_bf16(pa2, ATT_PK(v[4], v[5]), od, 0, 0, 0);
  od = __builtin_amdgcn_mfma_f32_32x32x16_bf16(pa3, ATT_PK(v[6], v[7]), od, 0, 0, 0);
#undef ATT_PK
}
#define ATT_LGKM(n) do { asm volatile("s_waitcnt lgkmcnt(" #n ")" ::: "memory"); ATT_SBAR(); } while (0)
template <int D0, int H> __device__ __forceinline__ void pvh_rd(s16x4 (&v)[4], int vb) {
  v[0] = tr_read<v_rd_off(D0, 2 * H, 0)>(vb); v[1] = tr_read<v_rd_off(D0, 2 * H, 1)>(vb); v[2] = tr_read<v_rd_off(D0, 2 * H + 1, 0)>(vb); v[3] = tr_read<v_rd_off(D0, 2 * H + 1, 1)>(vb);
}
__device__ __forceinline__ void pvh_mf(f32x16& od, const s16x4 (&v)[4], bf16x8 pa, bf16x8 pb) {
#define ATT_PK(L, H_) (bf16x8){L[0], L[1], L[2], L[3], H_[0], H_[1], H_[2], H_[3]}
  od = __builtin_amdgcn_mfma_f32_32x32x16_bf16(pa, ATT_PK(v[0], v[1]), od, 0, 0, 0);
  od = __builtin_amdgcn_mfma_f32_32x32x16_bf16(pb, ATT_PK(v[2], v[3]), od, 0, 0, 0);
#undef ATT_PK
}
__device__ __forceinline__ void pv_d0(f32x16* o, int vb, bf16x8 pa0, bf16x8 pa1, bf16x8 pa2, bf16x8 pa3) {
  pv_one<0>(o[0], vb, pa0, pa1, pa2, pa3); pv_one<1>(o[1], vb, pa0, pa1, pa2, pa3); pv_one<2>(o[2], vb, pa0, pa1, pa2, pa3); pv_one<3>(o[3], vb, pa0, pa1, pa2, pa3);
}

__device__ __forceinline__ float sm_rowmax(const f32x16& p0, const f32x16& p1) {
  float a = fmaxf(fmaxf(p0[0], p0[1]), p1[0]), b = fmaxf(fmaxf(p0[2], p0[3]), p1[1]); a = fmaxf(fmaxf(a, p1[2]), p1[3]);
#pragma unroll
  for (int r = 4; r < 16; r += 4) { a = fmaxf(fmaxf(a, p0[r]), p0[r + 1]); b = fmaxf(fmaxf(b, p0[r + 2]), p0[r + 3]); a = fmaxf(fmaxf(a, p1[r]), p1[r + 1]); b = fmaxf(fmaxf(b, p1[r + 2]), p1[r + 3]); }
  float pmax = fmaxf(a, b);
  auto rr = __builtin_amdgcn_permlane32_swap(__float_as_uint(pmax), __float_as_uint(pmax), false, false);
  return fmaxf(__uint_as_float(rr[0]), __uint_as_float(rr[1]));
}
__device__ __forceinline__ void sm_decide(float pmax, float& m_reg, float& mn, float& alpha) {
  if (__builtin_expect(__all(pmax - m_reg <= THR), 1)) { mn = m_reg; alpha = 1.f; }
  else { mn = fmaxf(m_reg, pmax); alpha = __builtin_amdgcn_exp2f(m_reg - mn); m_reg = mn; }
}
template <int LO, int HI> __device__ __forceinline__ void sm_sub(f32x16& p, float mn) {
#pragma unroll
  for (int r = LO; r < HI; ++r) p[r] = p[r] - mn;
}
template <int LO, int HI> __device__ __forceinline__ void sm_exp(f32x16& p) {
#pragma unroll
  for (int r = LO; r < HI; ++r) p[r] = __builtin_amdgcn_exp2f(p[r]);
}
__device__ __forceinline__ float fadd_s(float a, float b) { float r; asm("v_add_f32_e32 %0, %1, %2" : "=v"(r) : "v"(a), "v"(b)); return r; }
__device__ __forceinline__ void sm_sum(const f32x16& p0, const f32x16& p1, float alpha, float& l_reg) {
  float s0 = fadd_s(p0[0], p0[1]), s1 = fadd_s(p1[0], p1[1]);
#pragma unroll
  for (int r = 2; r < 16; ++r) { s0 = fadd_s(s0, p0[r]); s1 = fadd_s(s1, p1[r]); }
  float ps = s0 + s1;
  auto rr = __builtin_amdgcn_permlane32_swap(__float_as_uint(ps), __float_as_uint(ps), false, false);
  ps = __uint_as_float(rr[0]) + __uint_as_float(rr[1]);
  l_reg = l_reg * alpha + ps;
}
template <int BASE> __device__ __forceinline__ bf16x8 sm_pack(const f32x16& P) {
  const unsigned a0 = cvtpk(P[BASE + 0], P[BASE + 1]), a1 = cvtpk(P[BASE + 2], P[BASE + 3]), b0 = cvtpk(P[BASE + 4], P[BASE + 5]), b1 = cvtpk(P[BASE + 6], P[BASE + 7]);
  auto r0 = __builtin_amdgcn_permlane32_swap(a0, b0, false, false); auto r1 = __builtin_amdgcn_permlane32_swap(a1, b1, false, false);
  u32x4 w = {r0[0], r1[0], r0[1], r1[1]}; return *reinterpret_cast<bf16x8*>(&w);
}
template <int DQK> struct AttnCfg { static constexpr int SHM_V = KVBLK * 128 * 2, SHM_K = KVBLK * DQK * 2, NKB = SHM_K / 8192, SHM = 2 * SHM_V + 2 * SHM_K + NW * 64 * 4; };
typedef __attribute__((address_space(3))) unsigned char* ldsp_t;
template <int DQK, bool FAST>
__device__ __forceinline__ void attn_unit(const bf16* __restrict__ Qb, int ldq, const bf16* __restrict__ Kc, const bf16* __restrict__ Kl, int ldk,
                                          const bf16* __restrict__ Vc, const bf16* __restrict__ Vl, int ldv, bf16* __restrict__ Ob, int ldo, int NT, int nt_c, ldsp_t lds) {
  constexpr int SHM_V = AttnCfg<DQK>::SHM_V, SHM_K = AttnCfg<DQK>::SHM_K, NKB = AttnCfg<DQK>::NKB, NKC = DQK / 16, CPR = DQK / 8;
  const int tid = threadIdx.x, wid = __builtin_amdgcn_readfirstlane(tid >> 6), lane = tid & 63, r32 = lane & 31, hi = lane >> 5;
  const ldsp_t V_lds = lds; const ldsp_t K_lds = lds + 2 * SHM_V;
  __attribute__((address_space(3))) float* ws = (__attribute__((address_space(3))) float*)(lds + 122880) + wid * 64;
  __attribute__((address_space(3))) float* li_l = ws; __attribute__((address_space(3))) float* al_l = ws + 32;
  float m_reg = -1e30f, l_reg = 0; f32x16 o[4] = {}; bf16x8 qr[NKC];
  const bf16* Qw = Qb + (long)(wid * QBLK + r32) * ldq + hi * 8;
#pragma unroll
  for (int d0 = 0; d0 < NKC; ++d0) qr[d0] = *reinterpret_cast<const bf16x8*>(Qw + d0 * 16);
  const int vb0 = (int)(unsigned)(uintptr_t)V_lds + v_rd_base(lane);
  int koff[NKB], voff[2];
#pragma unroll
  for (int i = 0; i < NKB; ++i) { const int s_ = (wid + 8 * i) * 64 + lane, row_ = s_ / CPR, chp_ = s_ % CPR; koff[i] = row_ * ldk + ((chp_ ^ ((row_ >> 1) & 7)) << 3); }
#pragma unroll
  for (int i = 0; i < 2; ++i) { const int s_ = (wid + 8 * i) * 64 + lane, sub_ = s_ >> 5, kk_ = ((sub_ >> 2) << 3) | ((s_ >> 2) & 7), c_ = ((sub_ & 3) << 5) | ((s_ & 3) << 3);
    const int k_ = (kk_ & ~0xC) | ((kk_ & 4) << 1) | ((kk_ & 8) >> 1); voff[i] = k_ * ldv + c_; }
#define ATT_DMA(t, b) do { const int t_ = (t); const bool c_ = t_ < nt_c; const long k0_ = c_ ? (long)t_ * KVBLK : (long)(t_ - nt_c) * KVBLK; \
    const bf16* Kb_ = (c_ ? Kc : Kl) + k0_ * ldk; const bf16* Vb_ = (c_ ? Vc : Vl) + k0_ * ldv; \
    _Pragma("unroll") for (int i_ = 0; i_ < NKB; ++i_) __builtin_amdgcn_global_load_lds((const unsigned*)(Kb_ + koff[i_]), (__attribute__((address_space(3))) unsigned*)(K_lds + (b) * SHM_K + (wid + 8 * i_) * 1024), 16, 0, 0); \
    _Pragma("unroll") for (int i_ = 0; i_ < 2; ++i_) __builtin_amdgcn_global_load_lds((const unsigned*)(Vb_ + voff[i_]), (__attribute__((address_space(3))) unsigned*)(V_lds + (b) * SHM_V + (wid + 8 * i_) * 1024), 16, 0, 0); } while (0)
#define ATT_RESC(a) do { if (__any((a) < 1.f)) { if (hi == 0) al_l[r32] = (a); asm volatile("s_waitcnt lgkmcnt(0)" ::: "memory"); \
    _Pragma("unroll") for (int d = 0; d < 4; ++d) _Pragma("unroll") for (int r = 0; r < 16; ++r) o[d][r] *= al_l[crow(r, hi)]; } } while (0)
  bf16x8 pa0, pa1, pa2, pa3; f32x16 p0, p1; float mn, al;
  ATT_DMA(0, 0);
  asm volatile("s_waitcnt vmcnt(0)" ::: "memory"); __syncthreads();
  for (int j = 0; j < NT; ++j) {
    const int cur = j & 1;
    if (j + 1 < NT) { ATT_DMA(j + 1, cur ^ 1); }
    if constexpr (FAST) {
      const ldsp_t Kb_ = K_lds + cur * SHM_K; const int vbb = vb0 + cur * SHM_V;
      ATT_SBAR(); p0 = f32x16{};
#pragma unroll
      for (int d0 = 0; d0 < NKC; ++d0) { p0 = __builtin_amdgcn_mfma_f32_32x32x16_bf16(*(const __attribute__((address_space(3))) bf16x8*)(Kb_ + kswz<DQK>(r32, (d0 * 16 + hi * 8) * 2)), qr[d0], p0, 0, 0, 0); }
      ATT_SBAR(); p1 = f32x16{};
#pragma unroll
      for (int d0 = 0; d0 < NKC; ++d0) { p1 = __builtin_amdgcn_mfma_f32_32x32x16_bf16(*(const __attribute__((address_space(3))) bf16x8*)(Kb_ + kswz<DQK>(32 + r32, (d0 * 16 + hi * 8) * 2)), qr[d0], p1, 0, 0, 0); }
      sm_exp<0, 16>(p0); pa0 = sm_pack<0>(p0); pa1 = sm_pack<8>(p0);
      ATT_SBAR();
      s16x4 va_[4], vb2_[4];
      pvh_rd<0, 0>(va_, vbb); pvh_rd<1, 0>(vb2_, vbb); ATT_LGKM(4); pvh_mf(o[0], va_, pa0, pa1); sm_exp<0, 4>(p1); ATT_SBAR();
      pvh_rd<2, 0>(va_, vbb); ATT_LGKM(4); pvh_mf(o[1], vb2_, pa0, pa1); sm_exp<4, 8>(p1); ATT_SBAR();
      pvh_rd<3, 0>(vb2_, vbb); ATT_LGKM(4); pvh_mf(o[2], va_, pa0, pa1); sm_exp<8, 12>(p1); ATT_SBAR();
      pvh_rd<0, 1>(va_, vbb); ATT_LGKM(4); pvh_mf(o[3], vb2_, pa0, pa1); sm_exp<12, 16>(p1); sm_sum(p0, p1, 1.f, l_reg); pa2 = sm_pack<0>(p1); pa3 = sm_pack<8>(p1); ATT_SBAR();
      pvh_rd<1, 1>(vb2_, vbb); ATT_LGKM(4); pvh_mf(o[0], va_, pa2, pa3); ATT_SBAR();
      pvh_rd<2, 1>(va_, vbb); ATT_LGKM(4); pvh_mf(o[1], vb2_, pa2, pa3); ATT_SBAR();
      pvh_rd<3, 1>(vb2_, vbb); ATT_LGKM(4); pvh_mf(o[2], va_, pa2, pa3); ATT_SBAR();
      ATT_LGKM(0); pvh_mf(o[3], vb2_, pa2, pa3);
    } else {
    ATT_SBAR(); qkt<DQK>(p0, p1, K_lds + cur * SHM_K, qr, r32, hi);
    partialSM(p0, p1, m_reg, mn, al); ATT_RESC(al);
    finishSM(p0, p1, al, l_reg, pa0, pa1, pa2, pa3); ATT_SBAR();
    pv_d0(o, vb0 + cur * SHM_V, pa0, pa1, pa2, pa3);
    }
    asm volatile("s_waitcnt vmcnt(0)" ::: "memory"); __syncthreads();
  }
  if (hi == 0) li_l[r32] = l_reg; asm volatile("s_waitcnt lgkmcnt(0)" ::: "memory");
  float rli[16];
#pragma unroll
  for (int r = 0; r < 16; ++r) rli[r] = __builtin_amdgcn_rcpf(li_l[crow(r, hi)]);
  { __attribute__((address_space(3))) unsigned short* stg = (__attribute__((address_space(3))) unsigned short*)(lds) + wid * (32 * 136);
#pragma unroll
    for (int r = 0; r < 16; ++r) { const int orow = crow(r, hi);
#pragma unroll
      for (int d0 = 0; d0 < 4; ++d0) stg[orow * 136 + d0 * 32 + r32] = (unsigned short)(cvtpk(o[d0][r] * rli[r], 0.f) & 0xffffu); }
    asm volatile("s_waitcnt lgkmcnt(0)" ::: "memory");
    bf16* Ow = Ob + (long)(wid * QBLK) * ldo;
#pragma unroll
    for (int i = 0; i < 8; ++i) { const int row = i * 4 + (lane >> 4), ch = lane & 15; const u32x4 v = *(const __attribute__((address_space(3))) u32x4*)(stg + row * 136 + ch * 8); *(u32x4*)(Ow + (long)row * ldo + ch * 8) = v; } }
  __syncthreads();
#undef ATT_DMA
#undef ATT_RESC
}
template <int DQK, bool FAST>
__device__ __forceinline__ void attn_unit_pipe(const bf16* __restrict__ Qb, int ldq, const bf16* __restrict__ Kc, const bf16* __restrict__ Kl, int ldk,
                                          const bf16* __restrict__ Vc, const bf16* __restrict__ Vl, int ldv, bf16* __restrict__ Ob, int ldo, int NT, int nt_c, ldsp_t lds) {
  constexpr int SHM_V = AttnCfg<DQK>::SHM_V, SHM_K = AttnCfg<DQK>::SHM_K, NKB = AttnCfg<DQK>::NKB, NKC = DQK / 16, CPR = DQK / 8;
  const int tid = threadIdx.x, wid = __builtin_amdgcn_readfirstlane(tid >> 6), lane = tid & 63, r32 = lane & 31, hi = lane >> 5;
  const ldsp_t V_lds = lds; const ldsp_t K_lds = lds + 2 * SHM_V;
  __attribute__((address_space(3))) float* ws = (__attribute__((address_space(3))) float*)(lds + 122880) + wid * 64;
  __attribute__((address_space(3))) float* li_l = ws; __attribute__((address_space(3))) float* al_l = ws + 32;
  float m_reg = -1e30f, l_reg = 0; f32x16 o[4] = {}; bf16x8 qr[NKC];
  const bf16* Qw = Qb + (long)(wid * QBLK + r32) * ldq + hi * 8;
#pragma unroll
  for (int d0 = 0; d0 < NKC; ++d0) qr[d0] = *reinterpret_cast<const bf16x8*>(Qw + d0 * 16);
  const int vb0 = (int)(unsigned)(uintptr_t)V_lds + v_rd_base(lane);
  int koff[NKB], voff[2];
#pragma unroll
  for (int i = 0; i < NKB; ++i) { const int s_ = (wid + 8 * i) * 64 + lane, row_ = s_ / CPR, chp_ = s_ % CPR; koff[i] = row_ * ldk + ((chp_ ^ ((row_ >> 1) & 7)) << 3); }
#pragma unroll
  for (int i = 0; i < 2; ++i) { const int s_ = (wid + 8 * i) * 64 + lane, sub_ = s_ >> 5, kk_ = ((sub_ >> 2) << 3) | ((s_ >> 2) & 7), c_ = ((sub_ & 3) << 5) | ((s_ & 3) << 3);
    const int k_ = (kk_ & ~0xC) | ((kk_ & 4) << 1) | ((kk_ & 8) >> 1); voff[i] = k_ * ldv + c_; }
#define ATT_DMA(t, b) do { const int t_ = (t); const bool c_ = t_ < nt_c; const long k0_ = c_ ? (long)t_ * KVBLK : (long)(t_ - nt_c) * KVBLK; \
    const bf16* Kb_ = (c_ ? Kc : Kl) + k0_ * ldk; const bf16* Vb_ = (c_ ? Vc : Vl) + k0_ * ldv; \
    _Pragma("unroll") for (int i_ = 0; i_ < NKB; ++i_) __builtin_amdgcn_global_load_lds((const unsigned*)(Kb_ + koff[i_]), (__attribute__((address_space(3))) unsigned*)(K_lds + (b) * SHM_K + (wid + 8 * i_) * 1024), 16, 0, 0); \
    _Pragma("unroll") for (int i_ = 0; i_ < 2; ++i_) __builtin_amdgcn_global_load_lds((const unsigned*)(Vb_ + voff[i_]), (__attribute__((address_space(3))) unsigned*)(V_lds + (b) * SHM_V + (wid + 8 * i_) * 1024), 16, 0, 0); } while (0)
#define ATT_RESC(a) do { if (__any((a) < 1.f)) { if (hi == 0) al_l[r32] = (a); asm volatile("s_waitcnt lgkmcnt(0)" ::: "memory"); \
    _Pragma("unroll") for (int d = 0; d < 4; ++d) _Pragma("unroll") for (int r = 0; r < 16; ++r) o[d][r] *= al_l[crow(r, hi)]; } } while (0)
  bf16x8 pa0, pa1, pa2, pa3; f32x16 pA0, pA1, pB0, pB1; float mnA, mnB, alA, alB;
#define ATT_DMAK(t, b) do { const int t_ = (t); const bool c_ = t_ < nt_c; const long k0_ = c_ ? (long)t_ * KVBLK : (long)(t_ - nt_c) * KVBLK; const bf16* Kb_ = (c_ ? Kc : Kl) + k0_ * ldk; \
    _Pragma("unroll") for (int i_ = 0; i_ < NKB; ++i_) __builtin_amdgcn_global_load_lds((const unsigned*)(Kb_ + koff[i_]), (__attribute__((address_space(3))) unsigned*)(K_lds + (b) * SHM_K + (wid + 8 * i_) * 1024), 16, 0, 0); } while (0)
#define ATT_DMAV(t, b) do { const int t_ = (t); const bool c_ = t_ < nt_c; const long k0_ = c_ ? (long)t_ * KVBLK : (long)(t_ - nt_c) * KVBLK; const bf16* Vb_ = (c_ ? Vc : Vl) + k0_ * ldv; \
    _Pragma("unroll") for (int i_ = 0; i_ < 2; ++i_) __builtin_amdgcn_global_load_lds((const unsigned*)(Vb_ + voff[i_]), (__attribute__((address_space(3))) unsigned*)(V_lds + (b) * SHM_V + (wid + 8 * i_) * 1024), 16, 0, 0); } while (0)
#define ATT_ENDSTEP() do { asm volatile("s_waitcnt vmcnt(0)" ::: "memory"); __syncthreads(); } while (0)
  static_assert(DQK == 64, "the hand-interleaved step is written for a 64-wide QK");
#define ATT_KF(kb, d0, h) (*(const __attribute__((address_space(3))) bf16x8*)(K_lds + (kb) * SHM_K + kswz<DQK>((h) * 32 + r32, ((d0) * 16 + hi * 8) * 2)))
#define ATT_STEP(C0, C1, alC, mnC, P0, P1, alP, kb, vb) do { \
    bf16x8 kf_[8]; _Pragma("unroll") for (int d_ = 0; d_ < 4; ++d_) { kf_[2 * d_] = ATT_KF(kb, d_, 0); kf_[2 * d_ + 1] = ATT_KF(kb, d_, 1); } \
    C0 = f32x16{}; C1 = f32x16{}; \
    ATT_SBAR(); \
    C0 = __builtin_amdgcn_mfma_f32_32x32x16_bf16(kf_[0], qr[0], C0, 0, 0, 0); C1 = __builtin_amdgcn_mfma_f32_32x32x16_bf16(kf_[1], qr[0], C1, 0, 0, 0); sm_exp<0, 8>(P1); ATT_SBAR(); \
    C0 = __builtin_amdgcn_mfma_f32_32x32x16_bf16(kf_[2], qr[1], C0, 0, 0, 0); C1 = __builtin_amdgcn_mfma_f32_32x32x16_bf16(kf_[3], qr[1], C1, 0, 0, 0); sm_exp<8, 16>(P1); ATT_SBAR(); \
    C0 = __builtin_amdgcn_mfma_f32_32x32x16_bf16(kf_[4], qr[2], C0, 0, 0, 0); C1 = __builtin_amdgcn_mfma_f32_32x32x16_bf16(kf_[5], qr[2], C1, 0, 0, 0); sm_sum(P0, P1, alP, l_reg); pa0 = sm_pack<0>(P0); ATT_SBAR(); \
    C0 = __builtin_amdgcn_mfma_f32_32x32x16_bf16(kf_[6], qr[3], C0, 0, 0, 0); C1 = __builtin_amdgcn_mfma_f32_32x32x16_bf16(kf_[7], qr[3], C1, 0, 0, 0); pa1 = sm_pack<8>(P0); pa2 = sm_pack<0>(P1); pa3 = sm_pack<8>(P1); ATT_SBAR(); \
    if constexpr (FAST) { \
    const int vbb_ = vb0 + (vb) * SHM_V; s16x4 va_[8], vb2_[8]; \
    pv_rd<0>(va_, vbb_); pv_rd<1>(vb2_, vbb_); ATT_LGKM(8); pv_mf(o[0], va_, pa0, pa1, pa2, pa3); sm_exp<0, 4>(C0); ATT_SBAR(); \
    pv_rd<2>(va_, vbb_); ATT_LGKM(8); pv_mf(o[1], vb2_, pa0, pa1, pa2, pa3); sm_exp<4, 8>(C0); ATT_SBAR(); \
    pv_rd<3>(vb2_, vbb_); ATT_LGKM(8); pv_mf(o[2], va_, pa0, pa1, pa2, pa3); sm_exp<8, 12>(C0); ATT_SBAR(); \
    ATT_LGKM(0); pv_mf(o[3], vb2_, pa0, pa1, pa2, pa3); sm_exp<12, 16>(C0); ATT_SBAR(); alC = 1.f; \
    } else { \
    pv_one<0>(o[0], vb0 + (vb) * SHM_V, pa0, pa1, pa2, pa3); float pm_ = sm_rowmax(C0, C1); sm_decide(pm_, m_reg, mnC, alC); \
    pv_one<1>(o[1], vb0 + (vb) * SHM_V, pa0, pa1, pa2, pa3); sm_sub<0, 16>(C0, mnC); sm_sub<0, 16>(C1, mnC); \
    pv_one<2>(o[2], vb0 + (vb) * SHM_V, pa0, pa1, pa2, pa3); sm_exp<0, 8>(C0); \
    pv_one<3>(o[3], vb0 + (vb) * SHM_V, pa0, pa1, pa2, pa3); sm_exp<8, 16>(C0); ATT_SBAR(); \
    ATT_RESC(alC); } } while (0)
  ATT_DMAK(0, 0); ATT_DMAV(0, 0); ATT_ENDSTEP();
  ATT_DMAK(1, 1);
  qkt<DQK>(pA0, pA1, K_lds, qr, r32, hi);
  if constexpr (FAST) { sm_exp<0, 16>(pA0); alA = 1.f; mnA = 0.f; mnB = 0.f; alB = 1.f; } else { partialSM(pA0, pA1, m_reg, mnA, alA); }
  ATT_ENDSTEP();
  ATT_DMAK(2, 0); ATT_DMAV(1, 1);
  ATT_STEP(pB0, pB1, alB, mnB, pA0, pA1, alA, 1, 0);
  ATT_ENDSTEP();
  for (int j = 2; j < NT; j += 2) {
    if (j + 1 < NT) { ATT_DMAK(j + 1, 1); } ATT_DMAV(j, 0);
    ATT_STEP(pA0, pA1, alA, mnA, pB0, pB1, alB, 0, 1);
    ATT_ENDSTEP();
    if (j + 2 < NT) { ATT_DMAK(j + 2, 0); } ATT_DMAV(j + 1, 1);
    ATT_STEP(pB0, pB1, alB, mnB, pA0, pA1, alA, 1, 0);
    ATT_ENDSTEP();
  }
  finishSM(pB0, pB1, alB, l_reg, pa0, pa1, pa2, pa3); ATT_SBAR();
  pv_d0(o, vb0 + SHM_V, pa0, pa1, pa2, pa3);
  __syncthreads();
#undef ATT_STEP
#undef ATT_KF
#undef ATT_DMAK
#undef ATT_DMAV
#undef ATT_ENDSTEP
  if (hi == 0) li_l[r32] = l_reg; asm volatile("s_waitcnt lgkmcnt(0)" ::: "memory");
  float rli[16];
#pragma unroll
  for (int r = 0; r < 16; ++r) rli[r] = __builtin_amdgcn_rcpf(li_l[crow(r, hi)]);
  { __attribute__((address_space(3))) unsigned short* stg = (__attribute__((address_space(3))) unsigned short*)(lds) + wid * (32 * 136);
#pragma unroll
    for (int r = 0; r < 16; ++r) { const int orow = crow(r, hi);
#pragma unroll
      for (int d0 = 0; d0 < 4; ++d0) stg[orow * 136 + d0 * 32 + r32] = (unsigned short)(cvtpk(o[d0][r] * rli[r], 0.f) & 0xffffu); }
    asm volatile("s_waitcnt lgkmcnt(0)" ::: "memory");
    bf16* Ow = Ob + (long)(wid * QBLK) * ldo;
#pragma unroll
    for (int i = 0; i < 8; ++i) { const int row = i * 4 + (lane >> 4), ch = lane & 15; const u32x4 v = *(const __attribute__((address_space(3))) u32x4*)(stg + row * 136 + ch * 8); *(u32x4*)(Ow + (long)row * ldo + ch * 8) = v; } }
  __syncthreads();
#undef ATT_DMA
#undef ATT_RESC
}
}
constexpr float LOG2E = 1.4426950408889634f;
__device__ __forceinline__ void rope_table_phase(Frame& F, const Args& a) {
    float* RC = (float*)(a.ws + WS_ROPE); float* RS = RC + SEQ * 32;
    for (int i = blockIdx.x * (NWAVES * 64) + F.tid; i < SEQ * 32; i += F.G * NWAVES * 64) {
        const int t = i >> 5, p = i & 31;
        const float inv = powf(10000.0f, -(float)(p & 15) / 16.0f);
        const float ang = (float)(p < 16 ? (t >> 6) : (t & 63)) * inv;
        RC[i] = cosf(ang); RS[i] = sinf(ang);
    }
}
__device__ __forceinline__ void unpack8(const v4u w, float* x) {
    x[0] = __uint_as_float(w.x << 16); x[1] = __uint_as_float(w.x & 0xffff0000u); x[2] = __uint_as_float(w.y << 16); x[3] = __uint_as_float(w.y & 0xffff0000u);
    x[4] = __uint_as_float(w.z << 16); x[5] = __uint_as_float(w.z & 0xffff0000u); x[6] = __uint_as_float(w.w << 16); x[7] = __uint_as_float(w.w & 0xffff0000u);
}
__device__ __forceinline__ v4u pack8(const float* x) { v4u w; w.x = pk2(x[0], x[1]); w.y = pk2(x[2], x[3]); w.z = pk2(x[4], x[5]); w.w = pk2(x[6], x[7]); return w; }
__device__ __forceinline__ void prep1_phase(Frame& F, const Args& a, int l) {
    bf16* PROJ = (bf16*)(a.ws + WS_PROJ);
    const float* RC = (const float*)(a.ws + WS_ROPE); const float* RS = RC + SEQ * 32;
    const float* gqc = a.in[I_QCN] + l * 512; const float* gkvc = a.in[I_KVCN] + l * 256;
    const float* gdq = a.in[I_DQN] + l * 64; const float* gdk = a.in[I_DKN] + l * 64;
    const int gw = blockIdx.x * NWAVES + F.wave, NGW = F.G * NWAVES, lane = F.lane;
    const bool isq = lane < 32;
    const f32x4 gq0 = *(const f32x4*)(gqc + lane * 8), gq1 = *(const f32x4*)(gqc + lane * 8 + 4), gkv = *(const f32x4*)(gkvc + lane * 4);
    f32x4 gnv[8];
#pragma unroll
    for (int c = 0; c < 8; ++c) gnv[c] = *(const f32x4*)((isq ? gdq : gdk) + (lane & 1) * 32 + c * 4);
#define P1_LOAD(m_, QC, KV, D) do { const bf16* r_ = PROJ + (size_t)(m_) * NPROJ; QC = *(const v4u*)(r_ + PC_QC + lane * 8); KV = *(const unsigned long long*)(r_ + PC_KVC + lane * 4); \
        _Pragma("unroll") for (int c_ = 0; c_ < 4; ++c_) D[c_] = *(const v4u*)(r_ + PC_DQ + lane * 32 + c_ * 8); } while (0)
    v4u n_qc = {}, n_d[4] = {}; unsigned long long n_kv = 0;
    if (gw < T) P1_LOAD(gw, n_qc, n_kv, n_d);
    for (int m = gw; m < T; m += NGW) {
        bf16* row = PROJ + (size_t)m * NPROJ;
        const bool isl = m < TL; const int t = m & (SEQ - 1);
        const v4u c_qc = n_qc; const unsigned long long c_kv = n_kv; v4u c_d[4];
#pragma unroll
        for (int c = 0; c < 4; ++c) c_d[c] = n_d[c];
        if (m + NGW < T) P1_LOAD(m + NGW, n_qc, n_kv, n_d);
        f32x4 cs[8], sn[8];
        if (isl) {
#pragma unroll
            for (int c = 0; c < 8; ++c) { cs[c] = *(const f32x4*)(RC + (size_t)t * 32 + c * 4); sn[c] = *(const f32x4*)(RS + (size_t)t * 32 + c * 4); }
        }
        { float x[8]; unpack8(c_qc, x); float ss = 0.f;
#pragma unroll
          for (int i = 0; i < 8; ++i) ss += x[i] * x[i];
          const float rstd = 1.0f / sqrtf(wave_sum(ss) * (1.f / 512.f) + EPSN);
#pragma unroll
          for (int i = 0; i < 4; ++i) { x[i] = x[i] * rstd * gq0[i]; x[4 + i] = x[4 + i] * rstd * gq1[i]; }
          *(v4u*)(row + PC_QC + lane * 8) = pack8(x); }
        { const unsigned long long raw = c_kv; const unsigned lo32 = (unsigned)raw, hi32 = (unsigned)(raw >> 32);
          float x0 = __uint_as_float(lo32 << 16), x1 = __uint_as_float(lo32 & 0xffff0000u), x2 = __uint_as_float(hi32 << 16), x3 = __uint_as_float(hi32 & 0xffff0000u);
          const float rstd = 1.0f / sqrtf(wave_sum(x0 * x0 + x1 * x1 + x2 * x2 + x3 * x3) * (1.f / 256.f) + EPSN);
          *(unsigned long long*)(row + PC_KVC + lane * 4) = (unsigned long long)pk2(x0 * rstd * gkv.x, x1 * rstd * gkv.y) | ((unsigned long long)pk2(x2 * rstd * gkv.z, x3 * rstd * gkv.w) << 32); }
        {
            static_assert(PC_DK == PC_DQ + 1024, "dq and dk adjacent");
            bf16* p = row + PC_DQ + lane * 32;
            const float osc = isq ? 0.125f * LOG2E : 1.0f;
            float x[32];
#pragma unroll
            for (int c = 0; c < 4; ++c) unpack8(c_d[c], x + c * 8);
            float ss = 0.f;
#pragma unroll
            for (int i = 0; i < 32; ++i) ss += x[i] * x[i];
            ss += __shfl_xor(ss, 1);
            const float rstd = 1.0f / sqrtf(ss * (1.f / 64.f) + EPSN);
#pragma unroll
            for (int c = 0; c < 8; ++c) {
#pragma unroll
                for (int i = 0; i < 4; ++i) x[c * 4 + i] = x[c * 4 + i] * rstd * gnv[c][i]; }
            if (isl) {
                const bool second = (lane & 1) != 0;
#pragma unroll
                for (int c = 0; c < 8; ++c) {
#pragma unroll
                    for (int i = 0; i < 4; ++i) { const float mine = x[c * 4 + i], other = __shfl_xor(mine, 1);
                        x[c * 4 + i] = second ? (other * sn[c][i] + mine * cs[c][i]) : (mine * cs[c][i] - other * sn[c][i]); } }
            }
#pragma unroll
            for (int i = 0; i < 32; ++i) x[i] *= osc;
#pragma unroll
            for (int c = 0; c < 4; ++c) *(v4u*)(p + c * 8) = pack8(x + c * 8);
        }
    }
#undef P1_LOAD
}
__device__ __forceinline__ void prep2_phase(Frame& F, const Args& a, int l) {
    bf16* PROJ = (bf16*)(a.ws + WS_PROJ); bf16* QRAW = (bf16*)(a.ws + WS_QRAW); bf16* KVRAW = (bf16*)(a.ws + WS_KVRAW); bf16* KN = (bf16*)(a.ws + WS_KN);
    const float* RC = (const float*)(a.ws + WS_ROPE); const float* RS = RC + SEQ * 32;
    const float* gq = a.in[I_QN] + l * 192; const float* gk = a.in[I_KN] + l * 192;
    const int gw = blockIdx.x * NWAVES + F.wave, NGW = F.G * NWAVES, lane = F.lane, h = lane >> 3, sub = lane & 7;
    const float qsc = 0.07216878364870322f * LOG2E;
    f32x4 gqn[4], gqr[2], gkn[4], gkr[2];
#pragma unroll
    for (int c = 0; c < 4; ++c) { gqn[c] = *(const f32x4*)(gq + sub * 16 + c * 4); gkn[c] = *(const f32x4*)(gk + sub * 16 + c * 4); }
#pragma unroll
    for (int c = 0; c < 2; ++c) { gqr[c] = *(const f32x4*)(gq + 128 + sub * 8 + c * 4); gkr[c] = *(const f32x4*)(gk + 128 + sub * 8 + c * 4); }
#define P2_LOAD(m_, R) do { const bf16* q_ = QRAW + (size_t)(m_) * 1536 + h * 192; const bf16* k_ = KVRAW + (size_t)(m_) * 2048 + h * 256 + sub * 16; \
        R[0] = *(const v4u*)(q_ + sub * 16); R[1] = *(const v4u*)(q_ + sub * 16 + 8); R[2] = *(const v4u*)(q_ + 128 + sub * 8); \
        R[3] = *(const v4u*)(k_); R[4] = *(const v4u*)(k_ + 8); R[5] = *(const v4u*)(PROJ + (size_t)(m_) * NPROJ + PC_KR + sub * 8); } while (0)
    v4u nx[6] = {};
    if (gw < T) P2_LOAD(gw, nx);
    for (int m = gw; m < T; m += NGW) {
        const bool isl = m < TL; const int t = m & (SEQ - 1);
        v4u cur[6];
#pragma unroll
        for (int i = 0; i < 6; ++i) cur[i] = nx[i];
        if (m + NGW < T) P2_LOAD(m + NGW, nx);
        const int pi = (sub & 3) * 8;
        f32x4 cs[2], sn[2];
        if (isl) {
#pragma unroll
            for (int c = 0; c < 2; ++c) { cs[c] = *(const f32x4*)(RC + (size_t)t * 32 + pi + c * 4); sn[c] = *(const f32x4*)(RS + (size_t)t * 32 + pi + c * 4); }
        }
#pragma unroll
        for (int w = 0; w < 2; ++w) {
            bf16* on = (w == 0 ? QRAW : KN) + (size_t)m * 1536 + h * 192 + sub * 16;
            bf16* orp = (w == 0 ? QRAW : KN) + (size_t)m * 1536 + h * 192 + 128 + sub * 8;
            float xn[16], xr[8];
            unpack8(cur[3 * w], xn); unpack8(cur[3 * w + 1], xn + 8); unpack8(cur[3 * w + 2], xr);
            float ss = 0.f;
#pragma unroll
            for (int i = 0; i < 16; ++i) ss += xn[i] * xn[i];
#pragma unroll
            for (int i = 0; i < 8; ++i) ss += xr[i] * xr[i];
            ss += __shfl_xor(ss, 1); ss += __shfl_xor(ss, 2); ss += __shfl_xor(ss, 4);
            const float rstd = 1.0f / sqrtf(ss * (1.f / 192.f) + EPSN);
            const float osc = w == 0 ? qsc : 1.0f;
#pragma unroll
            for (int c = 0; c < 4; ++c) { const f32x4 gv = w == 0 ? gqn[c] : gkn[c];
#pragma unroll
                for (int i = 0; i < 4; ++i) xn[c * 4 + i] = xn[c * 4 + i] * rstd * gv[i] * osc; }
#pragma unroll
            for (int c = 0; c < 2; ++c) { const f32x4 gv = w == 0 ? gqr[c] : gkr[c];
#pragma unroll
                for (int i = 0; i < 4; ++i) xr[c * 4 + i] = xr[c * 4 + i] * rstd * gv[i]; }
            if (isl) {
                const bool second = (sub & 4) != 0;
#pragma unroll
                for (int c = 0; c < 2; ++c) {
#pragma unroll
                    for (int i = 0; i < 4; ++i) { const float mine = xr[c * 4 + i], other = __shfl_xor(mine, 4);
                        xr[c * 4 + i] = second ? (other * sn[c][i] + mine * cs[c][i]) : (mine * cs[c][i] - other * sn[c][i]); } }
            }
#pragma unroll
            for (int i = 0; i < 8; ++i) xr[i] *= osc;
            *(v4u*)(on) = pack8(xn); *(v4u*)(on + 8) = pack8(xn + 8); *(v4u*)(orp) = pack8(xr);
        }
    }
#undef P2_LOAD
}
__device__ __forceinline__ void dcomb_phase(Frame& F, const Args& a, int l) {
    bf16* PROJ = (bf16*)(a.ws + WS_PROJ); const bf16* O12 = (const bf16*)(a.ws + WS_O12);
    const float* lp = a.in[I_DLAM] + l * 256; const float* go = a.in[I_DON] + l * 128;
    const int gw = blockIdx.x * NWAVES + F.wave, NGW = F.G * NWAVES, lane = F.lane, h = lane >> 3, sub = lane & 7;
    const float lam_init = l == 0 ? 0.2f : (0.8f - 0.6f * 0.7408182206817179f);
    const float s1 = wave_sum(lp[lane] * lp[64 + lane]), s2 = wave_sum(lp[128 + lane] * lp[192 + lane]);
    const float lam = expf(s1) - expf(s2) + lam_init;
#define DC_LOAD(m_, R) do { const bf16* p1_ = O12 + (size_t)(m_) * 2048 + (2 * h) * 128 + sub * 16; R[0] = *(const v4u*)(p1_); R[1] = *(const v4u*)(p1_ + 8); R[2] = *(const v4u*)(p1_ + 128); R[3] = *(const v4u*)(p1_ + 136); } while (0)
    v4u nx[4] = {};
    if (gw < T) DC_LOAD(gw, nx);
    f32x4 gov[4];
#pragma unroll
    for (int c = 0; c < 4; ++c) gov[c] = *(const f32x4*)(go + sub * 16 + c * 4);
    for (int m = gw; m < T; m += NGW) {
        v4u cur[4];
#pragma unroll
        for (int i = 0; i < 4; ++i) cur[i] = nx[i];
        if (m + NGW < T) DC_LOAD(m + NGW, nx);
        float x1[16], x2[16];
        unpack8(cur[0], x1); unpack8(cur[1], x1 + 8); unpack8(cur[2], x2); unpack8(cur[3], x2 + 8);
        float ss = 0.f;
#pragma unroll
        for (int i = 0; i < 16; ++i) { x1[i] = x1[i] - lam * x2[i]; ss += x1[i] * x1[i]; }
        ss += __shfl_xor(ss, 1); ss += __shfl_xor(ss, 2); ss += __shfl_xor(ss, 4);
        const float rstd = (1.0f / sqrtf(ss * (1.f / 128.f) + EPSN)) * (1.0f - lam_init);
#pragma unroll
        for (int c = 0; c < 4; ++c) { const f32x4 gv = gov[c];
#pragma unroll
            for (int i = 0; i < 4; ++i) x1[c * 4 + i] = x1[c * 4 + i] * rstd * gv[i]; }
        bf16* o = PROJ + (size_t)m * NPROJ + PC_DQ + h * 128 + sub * 16;
        *(v4u*)(o) = pack8(x1); *(v4u*)(o + 8) = pack8(x1 + 8);
    }
}
__device__ __forceinline__ void attn_phase(Frame& F, const Args& a, int l) {
    const bf16* PROJ = (const bf16*)(a.ws + WS_PROJ); const bf16* QRAW = (const bf16*)(a.ws + WS_QRAW); const bf16* KVRAW = (const bf16*)(a.ws + WS_KVRAW); const bf16* KN = (const bf16*)(a.ws + WS_KN);
    bf16* O12 = (bf16*)(a.ws + WS_O12); bf16* BB = (bf16*)(a.ws + WS_BB);
    const att::ldsp_t lds = (att::ldsp_t)(F.lds + RING_OFF);
    float gq = 0.f, gk = 0.f, gdq = 0.f, gdk = 0.f;
    { const float* pq = a.in[I_QN] + l * 192; const float* pk = a.in[I_KN] + l * 192; const float* pdq = a.in[I_DQN] + l * 64; const float* pdk = a.in[I_DKN] + l * 64;
      for (int i = F.lane; i < 192; i += 64) { gq = fmaxf(gq, fabsf(pq[i])); gk = fmaxf(gk, fabsf(pk[i])); }
      gdq = fabsf(pdq[F.lane]); gdk = fabsf(pdk[F.lane]);
#pragma unroll
      for (int o = 1; o < 64; o <<= 1) { gq = fmaxf(gq, __shfl_xor(gq, o)); gk = fmaxf(gk, __shfl_xor(gk, o)); gdq = fmaxf(gdq, __shfl_xor(gdq, o)); gdk = fmaxf(gdk, __shfl_xor(gdk, o)); } }
    const float Bmla = 192.f * gq * gk * 0.07216878364870322f * LOG2E, Bdif = 64.f * gdq * gdk * 0.125f * LOG2E;
    const bool fast = __builtin_amdgcn_readfirstlane((Bmla <= 100.f && Bdif <= 100.f) ? 1 : 0) != 0;
#define ATT_MLA_UNITS(FASTV) \
    for (int u = vcid; u < 1024 + (l == 0 ? 16 : 0); u += F.G) { \
        const bool cq = u >= 1024; const int v = cq ? u - 1024 : u; \
        const int b = cq ? (v >> 3) : (v >> 9), h = cq ? (v & 7) : ((v >> 6) & 7), qb = cq ? 0 : (v & 63); \
        const size_t qrow = cq ? (size_t)TL + b * CTXL : (size_t)b * SEQ + qb * 256, crow0 = (size_t)TL + b * CTXL, lrow0 = (size_t)b * SEQ; \
        att::attn_unit<192, FASTV>(QRAW + qrow * 1536 + h * 192, 1536, KN + crow0 * 1536 + h * 192, KN + lrow0 * 1536 + h * 192, 1536, \
                            KVRAW + crow0 * 2048 + h * 256 + 128, KVRAW + lrow0 * 2048 + h * 256 + 128, 2048, (bf16*)PROJ + qrow * NPROJ + PC_RX + h * 128, NPROJ, cq ? 4 : 260, 4, lds); }
#define ATT_DIF_UNITS(FASTV) \
    for (int u = vcid; u < 2048 + (l == 0 ? 32 : 0); u += F.G) {     \
        const bool cq = u >= 2048; const int v = cq ? u - 2048 : u; \
        const int b = cq ? (v >> 4) : (v >> 10), vh = cq ? (v & 15) : ((v >> 6) & 15), qb = cq ? 0 : (v & 63); \
        const size_t qrow = cq ? (size_t)TL + b * CTXL : (size_t)b * SEQ + qb * 256, crow0 = (size_t)TL + b * CTXL, lrow0 = (size_t)b * SEQ; \
        att::attn_unit_pipe<64, FASTV>(PROJ + qrow * NPROJ + PC_DQ + vh * 64, NPROJ, PROJ + crow0 * NPROJ + PC_DK + vh * 64, PROJ + lrow0 * NPROJ + PC_DK + vh * 64, NPROJ, \
                           PROJ + crow0 * NPROJ + PC_DV + (vh >> 1) * 128, PROJ + lrow0 * NPROJ + PC_DV + (vh >> 1) * 128, NPROJ, O12 + qrow * 2048 + vh * 128, 2048, cq ? 4 : 260, 4, lds); }
    const int vcid = (F.G == 256) ? (int)(((blockIdx.x & 7) >> 1) * 64 + (blockIdx.x & 1) * 32 + (blockIdx.x >> 3)) : (int)blockIdx.x;
    if (fast) { ATT_MLA_UNITS(true) ATT_DIF_UNITS(true) } else { ATT_MLA_UNITS(false) ATT_DIF_UNITS(false) }
#undef ATT_MLA_UNITS
#undef ATT_DIF_UNITS
}
constexpr int NPH = 17;
constexpr int NPHASES = 2 * NPH;
#ifndef PH_LIMIT
#define PH_LIMIT NPHASES
#endif
#if MK_FUSED
#define GRID_BAR() xcd_barrier(bar)
#else
#define GRID_BAR() do {} while (0)
#endif
#define IN(k) (lo <= (k) && (k) < hi)
#define SEAM(k) do { if (IN(k) && IN((k) + 1)) GRID_BAR(); } while (0)
template <int l> __device__ __forceinline__ void layer_phases(Frame& F, const Args& args, const XcdBarrier& bar, const int lo, const int hi) {
    unsigned char* ws = args.ws;
    float* MOD = (float*)(ws + WS_MOD);
    float* XC = (float*)(ws + WS_XC);
    bf16* H = (bf16*)(ws + WS_H);
    bf16* PROJ = (bf16*)(ws + WS_PROJ);
    bf16* AFF = PROJ;
    unsigned char* wb = ws + WS_W;
    float* PART = (float*)(ws + WS_QRAW);
    const int cid = (int)blockIdx.x;
        const int pb = l * NPH;
        const float* xl_in = l == 0 ? args.in[I_X] : args.out;
        const float* xc_in = l == 0 ? args.in[I_CTX] : XC;
        const float* MODl = MOD + (size_t)l * 3 * NMOD;
        if (IN(pb + 0)) { conv_phase(F, args, l); if (l == 0) { rope_table_phase(F, args); __syncthreads(); mod_phase(F, args); } }
        SEAM(pb + 0);
        if (IN(pb + 1)) { if constexpr (l == 0) norm_phase(F, args, l, 0, xl_in, xc_in); else norm_phase(F, args, l, 0, xl_in, xc_in, PART, 11, XC); }
        SEAM(pb + 1);
        if (IN(pb + 2)) { pg8::Gemm g{H, (const bf16*)(wb + W_GU), T, 2 * DFF, DM, DM, DM}; pg8::StaticOrder S; S.init(T, 2 * DFF, F.G, cid);
            pg8::EpiSwiglu E{AFF, DFF}; pg8::gemm_phase<pg8::EpiSwiglu, pg8::StaticOrder, true, true>(F.lds + RING_OFF, g, S, E); }
        SEAM(pb + 2);
        if (IN(pb + 3)) { pg8::Gemm g{AFF, (const bf16*)(wb + W_D), T, DM, DFF, DFF, DFF}; pg8::SplitTailOrder<DFF, 11> S; S.init(TL, DM, 2, F.G, cid);
            pg8::EpiResid E{xl_in, xc_in, args.out, XC, MODl + 2 * DM, PART, 0.5f}; pg8::gemm_phase<pg8::EpiResid, pg8::SplitTailOrder<DFF, 11>, true, true>(F.lds + RING_OFF, g, S, E); }
        SEAM(pb + 3);
        if (IN(pb + 4)) norm_phase(F, args, l, 1, args.out, xc_in, PART, 11, XC);
        SEAM(pb + 4);
        if (IN(pb + 5)) { pg8::Gemm g{H, (const bf16*)(wb + W_IN), T, NPROJ, DM, DM, DM}; pg8::StaticOrder S; S.init(T, NPROJ, F.G, cid);
            pg8::EpiAct<1> E{PROJ, NPROJ}; pg8::gemm_phase<pg8::EpiAct<1>, pg8::StaticOrder, true, true>(F.lds + RING_OFF, g, S, E); }
        SEAM(pb + 5);
        if (IN(pb + 6)) { prep1_phase(F, args, l); lru_phase<false>(F, args, l); }
        SEAM(pb + 6);
        if (IN(pb + 7)) {
            { pg8::Gemm g{PROJ + PC_QC, (const bf16*)(wb + W_UQ), T, 1536, 512, NPROJ, 512}; pg8::StaticOrder S; S.init(T, 1536, F.G, cid);
              pg8::EpiAct<0> E{(bf16*)(ws + WS_QRAW), 1536}; pg8::gemm_phase<pg8::EpiAct<0>, pg8::StaticOrder, true, true>(F.lds + RING_OFF, g, S, E); }
            { pg8::Gemm g{PROJ + PC_KVC, (const bf16*)(wb + W_UKV), T, 2048, 256, NPROJ, 256}; pg8::StaticOrder S; S.init(T, 2048, F.G, cid);
              pg8::EpiAct<0> E{(bf16*)(ws + WS_KVRAW), 2048}; pg8::gemm_phase<pg8::EpiAct<0>, pg8::StaticOrder, true, true>(F.lds + RING_OFF, g, S, E); }
            lru_phase<true>(F, args, l);
        }
        SEAM(pb + 7);
        if (IN(pb + 8)) prep2_phase(F, args, l);
        SEAM(pb + 8);
        if (IN(pb + 9)) attn_phase(F, args, l);
        SEAM(pb + 9);
        constexpr int MT = (l == 1) ? TL : T;
        if (IN(pb + 10) || IN(pb + 11)) { if (IN(pb + 10)) dcomb_phase(F, args, l); }
        if (IN(pb + 11)) { pg8::Gemm g{H, (const bf16*)(wb + W_GT), MT, NPROJ, DM, DM, DM}; pg8::StaticOrder S; S.init(MT, NPROJ, F.G, cid);
            pg8::EpiAct<2> E{(bf16*)(ws + WS_GATES), NPROJ}; pg8::gemm_phase<pg8::EpiAct<2>, pg8::StaticOrder, true, true>(F.lds + RING_OFF, g, S, E); }
        SEAM(pb + 11);
        if (IN(pb + 12)) {
            pg8::Gemm g{PROJ, (const bf16*)(wb + W_BP), MT, DM, 1024, NPROJ, 1024}; using MO = pg8::MergeOrder<(unsigned)PC_RG * 2u, (unsigned)PC_RX * 2u, (unsigned)PC_DQ * 2u, (unsigned)W_BP_SZ>; MO S; S.init(MT, DM, F.G, cid);
            pg8::EpiMergeRT E{H, (const bf16*)(ws + WS_GATES)}; pg8::gemm_phase<pg8::EpiMergeRT, MO, true, true>(F.lds + RING_OFF, g, S, E); }
        SEAM(pb + 12);
        if (IN(pb + 13)) { pg8::Gemm g{H, (const bf16*)(wb + W_OUT), MT, DM, DM, DM, DM}; pg8::StaticOrder S; S.init(MT, DM, F.G, cid);
            pg8::EpiResid E{args.out, XC, args.out, XC, MODl + 5 * DM, nullptr, 1.0f}; pg8::gemm_phase<pg8::EpiResid, pg8::StaticOrder, true, true>(F.lds + RING_OFF, g, S, E); }
        SEAM(pb + 13);
        if (IN(pb + 14)) norm_phase(F, args, l, 2, args.out, XC);
        SEAM(pb + 14);
        if (IN(pb + 15)) { pg8::Gemm g{H, (const bf16*)(wb + W_GU + W_GU_SZ), MT, 2 * DFF, DM, DM, DM}; pg8::StaticOrder S; S.init(MT, 2 * DFF, F.G, cid);
            pg8::EpiSwiglu E{AFF, DFF}; pg8::gemm_phase<pg8::EpiSwiglu, pg8::StaticOrder, true, true>(F.lds + RING_OFF, g, S, E); }
        SEAM(pb + 15);
        if (IN(pb + 16)) { pg8::Gemm g{AFF, (const bf16*)(wb + W_D + W_D_SZ), MT, DM, DFF, DFF, DFF}; pg8::SplitTailOrder<DFF, 11> S; S.init(TL, DM, l == 1 ? 0 : 2, F.G, cid);
            pg8::EpiResid E{args.out, XC, args.out, XC, MODl + 8 * DM, PART, 0.5f}; pg8::gemm_phase<pg8::EpiResid, pg8::SplitTailOrder<DFF, 11>, true, true>(F.lds + RING_OFF, g, S, E); }
        SEAM(pb + 16);

    }
#undef IN
#undef SEAM
__global__ void __launch_bounds__(NWAVES * 64, 2) fwd(Args args) {
    extern __shared__ __attribute__((aligned(16))) unsigned char lds[];
    Frame F;
    F.lds = (LAS unsigned char*)lds;
    F.MISC = (volatile LAS unsigned*)(F.lds + MISC_OFF);
    F.tid = threadIdx.x; F.lane = F.tid & 63; F.wave = __builtin_amdgcn_readfirstlane(F.tid >> 6);
    F.G = gridDim.x;
    F.ctl = (gu32*)(args.ws + WS_CTL);
    for (int u = F.tid; u < (LDS_BYTES - LDSCTL_OFF) / 4; u += NWAVES * 64) ((LAS unsigned*)(F.lds + LDSCTL_OFF))[u] = 0u;
    __syncthreads();
#if MK_FUSED
    XcdBarrier bar = xcd_barrier_post((unsigned*)(F.ctl + CW_BAR), F.MISC + 8);
#else
    XcdBarrier bar; bar.bar = nullptr; bar.x = 0; bar.st = nullptr;
#endif
    layer_phases<0>(F, args, bar, args.ph_lo, args.ph_hi);
    layer_phases<1>(F, args, bar, args.ph_lo, args.ph_hi);
}

extern "C" void kernel_launch(void* const* d_in, const int* in_sizes, int n_in, void* d_out, int out_size, void* d_ws, size_t ws_size, hipStream_t stream) {
    static int grid = 0;
    if (grid == 0) {
        if (n_in != N_INPUTS || in_sizes[0] != TL * DM || out_size != TL * DM || ws_size < WS_END) { fprintf(stderr, "kernel_launch: shape/workspace mismatch (n_in %d, ws %zu, need %zu)\n", n_in, ws_size, (size_t)WS_END); grid = -1; return; }
        int dev = 0, cus = 0, per_cu = 0;
        if (hipGetDevice(&dev) != hipSuccess || hipDeviceGetAttribute(&cus, hipDeviceAttributeMultiprocessorCount, dev) != hipSuccess) { grid = -1; return; }
        if (hipFuncSetAttribute((const void*)fwd, hipFuncAttributeMaxDynamicSharedMemorySize, LDS_BYTES) != hipSuccess) { fprintf(stderr, "kernel_launch: hipFuncSetAttribute failed\n"); grid = -1; return; }
        if (hipOccupancyMaxActiveBlocksPerMultiprocessor(&per_cu, (const void*)fwd, NWAVES * 64, LDS_BYTES) != hipSuccess || per_cu < 1) fprintf(stderr, "kernel_launch: occupancy query reports %d\n", per_cu);
        (void)hipGetLastError();
        grid = cus;
    }
    if (grid < 0) return;
    if (hipMemsetAsync((char*)d_ws + WS_CTL, 0, CTL_ZERO_BYTES, stream) != hipSuccess) return;
    Args a{};
    for (int i = 0; i < N_INPUTS; ++i) a.in[i] = (const float*)d_in[i];
    a.out = (float*)d_out; a.ws = (unsigned char*)d_ws;
#if MK_FUSED
    a.ph_lo = 0; a.ph_hi = PH_LIMIT;
    hipLaunchKernelGGL(fwd, dim3(grid), dim3(NWAVES * 64), LDS_BYTES, stream, a);
#else
    for (int ph = 0; ph < PH_LIMIT; ++ph) { a.ph_lo = ph; a.ph_hi = ph + 1; hipLaunchKernelGGL(fwd, dim3(grid), dim3(NWAVES * 64), LDS_BYTES, stream, a); }
#endif
    const hipError_t le = hipPeekAtLastError();
    if (le != hipSuccess) fprintf(stderr, "kernel_launch: launch failed: %s\n", hipGetErrorName(le));
}
```
